# Optimizing an MI355X kernel written in HIP

```python
import jax
import jax.numpy as jnp
from jax import lax
import numpy as np

D_MODEL = 1024
BATCH = 8
SEQ = 2048
DEPTH = 4

GRID_W = 64
CTX_LEN = 256
CHUNK = 64
N_MIXERS = 2
RET_HEADS = 4
RET_QK = D_MODEL
RET_V = 2 * D_MODEL
RET_DK = RET_QK // RET_HEADS
RET_DV = RET_V // RET_HEADS
RET_IN = 2 * RET_QK + 2 * RET_V
GLA_HEADS = 4
GLA_K = D_MODEL // 2
GLA_V = D_MODEL
GLA_DK = GLA_K // GLA_HEADS
GLA_DV = GLA_V // GLA_HEADS
GLA_GATE_RANK = 16
GLA_TAU = 16.0
GLA_IN = 2 * GLA_K + 2 * GLA_V + 2 * GLA_GATE_RANK
D_FF = ((8 * D_MODEL // 3 + 255) // 256) * 256
N_EXPERTS = 8
TOP_K = 2
D_FF_EXPERT = 7 * D_MODEL // 2
ROPE_BASE = 10000.0
EPS = 1e-6
N_RET = (DEPTH + 1) // 2
N_GLA = DEPTH // 2

kernel_name = 'hybrid_retention_gla_moe_prefix_dit'


def rmsnorm(x, g):
    xf = x.astype(jnp.float32)
    y = xf * lax.rsqrt(jnp.mean(xf * xf, axis=-1, keepdims=True) + EPS)
    return (y * g.astype(jnp.float32)).astype(x.dtype)


def flip(t):
    return jnp.flip(t, axis=1)


def to_chunks(t):
    b, l, h, d = t.shape
    return t.reshape(b, l // CHUNK, CHUNK, h, d).transpose(1, 0, 3, 2, 4)


def from_chunks(t):
    n, b, h, c, d = t.shape
    return t.transpose(1, 0, 3, 2, 4).reshape(b, n * c, h, d)


def rope_1d(t, pos):
    half = t.shape[-1] // 2
    freqs = ROPE_BASE ** (-jnp.arange(half, dtype=jnp.float32) / half)
    ang = pos[:, None] * freqs[None, :]
    cos = jnp.cos(ang)[None, :, None, :].astype(t.dtype)
    sin = jnp.sin(ang)[None, :, None, :].astype(t.dtype)
    t1, t2 = t[..., :half], t[..., half:]
    return jnp.concatenate([t1 * cos - t2 * sin, t1 * sin + t2 * cos], axis=-1)


def rope_axial(t):
    length = t.shape[1]
    rows = length // GRID_W
    row = jnp.broadcast_to(jnp.arange(rows, dtype=jnp.float32)[:, None], (rows, GRID_W)).reshape(length)
    col = jnp.broadcast_to(jnp.arange(GRID_W, dtype=jnp.float32)[None, :], (rows, GRID_W)).reshape(length)
    half = t.shape[-1] // 2
    return jnp.concatenate([rope_1d(t[..., :half], row), rope_1d(t[..., half:], col)], axis=-1)


def retention_scan(q, k, v, log_gamma, state0):
    pos = jnp.arange(CHUNK, dtype=jnp.float32)
    lg = log_gamma.astype(jnp.float32)
    diff = pos[:, None] - pos[None, :]
    dmat = jnp.where(diff >= 0, jnp.exp(lg[:, None, None] * jnp.maximum(diff, 0.0)), 0.0)
    q_decay = jnp.exp(lg[:, None] * (pos + 1.0))[:, :, None]
    k_decay = jnp.exp(lg[:, None] * (CHUNK - 1.0 - pos))[:, :, None]
    chunk_decay = jnp.exp(lg * CHUNK)[:, None, None]

    def step(s, inp):
        qc, kc, vc = inp
        scores = jnp.einsum('bhid,bhjd->bhij', qc, kc) * dmat
        o = jnp.einsum('bhij,bhjv->bhiv', scores, vc) + jnp.einsum('bhid,bhdv->bhiv', qc * q_decay, s)
        s = s * chunk_decay + jnp.einsum('bhjd,bhjv->bhdv', kc * k_decay, vc)
        return s, o

    s, o = lax.scan(step, state0, (to_chunks(q), to_chunks(k), to_chunks(v)))
    return from_chunks(o), s


def retention_state(k, v, log_gamma):
    length = k.shape[1]
    t = jnp.arange(length, dtype=jnp.float32)
    w = jnp.exp(log_gamma.astype(jnp.float32)[None, :] * (length - 1.0 - t)[:, None])
    return jnp.einsum('blhd,blhv->bhdv', k * w[None, :, :, None], v).astype(jnp.float32)


def gla_scan(q, k, v, log_a, state0):
    causal = jnp.tril(jnp.ones((CHUNK, CHUNK), dtype=bool))[:, :, None]

    def step(s, inp):
        qc, kc, vc, gc = inp
        b = jnp.cumsum(gc, axis=2)
        rel = jnp.where(causal, b[:, :, :, None, :] - b[:, :, None, :, :], -jnp.inf)
        scores = jnp.einsum('bhjd,bhid,bhjid->bhji', qc, kc, jnp.exp(rel))
        o = jnp.einsum('bhji,bhiv->bhjv', scores, vc) + jnp.einsum('bhjd,bhdv->bhjv', qc * jnp.exp(b), s)
        b_last = b[:, :, -1:, :]
        s = s * jnp.exp(b_last)[:, :, 0, :, None] + jnp.einsum('bhid,bhiv->bhdv', kc * jnp.exp(b_last - b), vc)
        return s, o

    s, o = lax.scan(step, state0, (to_chunks(q), to_chunks(k), to_chunks(v), to_chunks(log_a)))
    return from_chunks(o), s


def gla_state(k, v, log_a):
    b = jnp.cumsum(log_a, axis=1)
    return jnp.einsum('blhd,blhv->bhdv', k * jnp.exp(b[:, -1:] - b), v).astype(jnp.float32)


def retention_mixer(h_ctx, h_lat, w_in, log_decay, gn_w, gn_b, w_out, with_ctx_out):
    batch = h_lat.shape[0]
    log_gamma = -jnp.exp(log_decay.astype(jnp.float32))
    qs = RET_QK + RET_V

    def query_side(p):
        b, l, _ = p.shape
        return p[..., :RET_QK].reshape(b, l, RET_HEADS, RET_DK), p[..., RET_QK:]

    def state_side(p):
        b, l, _ = p.shape
        k = p[..., :RET_QK].reshape(b, l, RET_HEADS, RET_DK) * (RET_DK ** -0.5)
        return k, p[..., RET_QK:].reshape(b, l, RET_HEADS, RET_DV)

    def finish(o, g):
        b, l = o.shape[:2]
        mu = jnp.mean(o, axis=-1, keepdims=True)
        var = jnp.mean(jnp.square(o - mu), axis=-1, keepdims=True)
        o = ((o - mu) * lax.rsqrt(var + EPS)).reshape(b, l, RET_V)
        o = (o * gn_w.astype(jnp.float32) + gn_b.astype(jnp.float32)).astype(g.dtype)
        return (o * jax.nn.silu(g)) @ w_out

    zeros = jnp.zeros((batch, RET_HEADS, RET_DK, RET_DV), jnp.float32)
    p_lat = h_lat @ w_in
    ql, gl = query_side(p_lat[..., :qs])
    kl, vl = state_side(p_lat[..., qs:])
    ql, kl = rope_axial(ql), rope_axial(kl)
    if with_ctx_out:
        p_ctx = h_ctx @ w_in
        qc, gc = query_side(p_ctx[..., :qs])
        kc, vc = state_side(p_ctx[..., qs:])
        oc_f, s_f = retention_scan(qc, kc, vc, log_gamma[0], zeros)
        oc_b, s_b = retention_scan(flip(qc), flip(kc), flip(vc), log_gamma[1], zeros)
        out_ctx = finish(oc_f + flip(oc_b), gc)
    else:
        kc, vc = state_side(h_ctx @ w_in[:, qs:])
        s_f = retention_state(kc, vc, log_gamma[0])
        s_b = retention_state(flip(kc), flip(vc), log_gamma[1])
        out_ctx = None
    ol_f, _ = retention_scan(ql, kl, vl, log_gamma[0], s_f)
    ol_b, _ = retention_scan(flip(ql), flip(kl), flip(vl), log_gamma[1], s_b)
    out_lat = finish(ol_f + flip(ol_b), gl)
    return out_lat, out_ctx


def gla_log_gate(a, w_up, b):
    z = (a @ w_up + b).astype(jnp.float32)
    return (jax.nn.log_sigmoid(z) / GLA_TAU).reshape(a.shape[0], a.shape[1], GLA_HEADS, GLA_DK)


def gla_mixer(h_ctx, h_lat, w_in, w_gate_up, b_gate, norm_g, w_out, with_ctx_out):
    batch = h_lat.shape[0]
    qs = GLA_K + GLA_V

    def query_side(p):
        b, l, _ = p.shape
        q = p[..., :GLA_K].reshape(b, l, GLA_HEADS, GLA_DK) * (GLA_DK ** -0.5)
        return q, p[..., GLA_K:]

    def state_side(p):
        b, l, _ = p.shape
        k = p[..., :GLA_K].reshape(b, l, GLA_HEADS, GLA_DK)
        v = p[..., GLA_K:GLA_K + GLA_V].reshape(b, l, GLA_HEADS, GLA_DV)
        a_f = p[..., GLA_K + GLA_V:GLA_K + GLA_V + GLA_GATE_RANK]
        a_b = p[..., GLA_K + GLA_V + GLA_GATE_RANK:]
        return k, v, gla_log_gate(a_f, w_gate_up[0], b_gate[0]), gla_log_gate(a_b, w_gate_up[1], b_gate[1])

    def finish(o, r):
        b, l = o.shape[:2]
        o = o * lax.rsqrt(jnp.mean(o * o, axis=-1, keepdims=True) + EPS)
        o = (o.reshape(b, l, GLA_V) * norm_g.astype(jnp.float32)).astype(r.dtype)
        return (o * jax.nn.silu(r)) @ w_out

    zeros = jnp.zeros((batch, GLA_HEADS, GLA_DK, GLA_DV), jnp.float32)
    p_lat = h_lat @ w_in
    ql, rl = query_side(p_lat[..., :qs])
    kl, vl, laf_l, lab_l = state_side(p_lat[..., qs:])
    if with_ctx_out:
        p_ctx = h_ctx @ w_in
        qc, rc = query_side(p_ctx[..., :qs])
        kc, vc, laf_c, lab_c = state_side(p_ctx[..., qs:])
        oc_f, s_f = gla_scan(qc, kc, vc, laf_c, zeros)
        oc_b, s_b = gla_scan(flip(qc), flip(kc), flip(vc), flip(lab_c), zeros)
        out_ctx = finish(oc_f + flip(oc_b), rc)
    else:
        kc, vc, laf_c, lab_c = state_side(h_ctx @ w_in[:, qs:])
        s_f = gla_state(kc, vc, laf_c)
        s_b = gla_state(flip(kc), flip(vc), flip(lab_c))
        out_ctx = None
    ol_f, _ = gla_scan(ql, kl, vl, laf_l, s_f)
    ol_b, _ = gla_scan(flip(ql), flip(kl), flip(vl), flip(lab_l), s_b)
    out_lat = finish(ol_f + flip(ol_b), rl)
    return out_lat, out_ctx


def swiglu(h, w_gate, w_up, w_down):
    return (jax.nn.silu(h @ w_gate) * (h @ w_up)) @ w_down


def moe_swiglu(h, w_router, w_gate, w_up, w_down):
    logits = (h @ w_router).astype(jnp.float32)
    top_vals, top_idx = lax.top_k(logits, TOP_K)
    top_w = jax.nn.softmax(top_vals, axis=-1)
    gates = jnp.sum(jax.nn.one_hot(top_idx, N_EXPERTS, dtype=jnp.float32) * top_w[..., None], axis=-2)
    out = jnp.zeros_like(h)
    for e in range(N_EXPERTS):
        out = out + gates[..., e:e + 1].astype(h.dtype) * swiglu(h, w_gate[e], w_up[e], w_down[e])
    return out


def setup_inputs(seed: int = 0) -> dict:
    key = jax.random.key(seed)
    keys = iter(jax.random.split(key, 32))
    f32 = jnp.float32
    d = D_MODEL

    def nrm(shape, scale):
        return jax.random.normal(next(keys), shape, f32) * scale

    base_decay = jnp.log(-jnp.log1p(-(2.0 ** (-5.0 - jnp.arange(RET_HEADS, dtype=f32)))))
    return {
        'x': nrm((BATCH, SEQ, d), 1.0),
        'c': nrm((BATCH, d), 1.0),
        'ctx': nrm((BATCH, CTX_LEN, d), 1.0),
        'c_ctx': nrm((d,), 1.0),
        'ada_w': nrm((DEPTH, d, 6 * d), 0.5 * d ** -0.5),
        'ada_b': nrm((DEPTH, 6 * d), 0.02),
        'norm_mix_g': 1.0 + nrm((DEPTH, d), 0.02),
        'norm_ffn_g': 1.0 + nrm((DEPTH, d), 0.02),
        'final_g': 1.0 + nrm((d,), 0.02),
        'ret_w_in': nrm((N_RET, d, RET_IN), d ** -0.5),
        'ret_log_decay': base_decay[None, None, :] + nrm((N_RET, 2, RET_HEADS), 0.1),
        'ret_gn_w': 1.0 + nrm((N_RET, RET_V), 0.02),
        'ret_gn_b': nrm((N_RET, RET_V), 0.02),
        'ret_w_out': nrm((N_RET, RET_V, d), RET_V ** -0.5),
        'gla_w_in': nrm((N_GLA, d, GLA_IN), d ** -0.5),
        'gla_w_gate_up': nrm((N_GLA, 2, GLA_GATE_RANK, GLA_K), GLA_GATE_RANK ** -0.5),
        'gla_b_gate': nrm((N_GLA, 2, GLA_K), 0.1),
        'gla_norm_g': 1.0 + nrm((N_GLA, GLA_V), 0.02),
        'gla_w_out': nrm((N_GLA, GLA_V, d), GLA_V ** -0.5),
        'ffn_w_gate': nrm((N_RET, d, D_FF), d ** -0.5),
        'ffn_w_up': nrm((N_RET, d, D_FF), d ** -0.5),
        'ffn_w_down': nrm((N_RET, D_FF, d), D_FF ** -0.5),
        'moe_w_router': nrm((N_GLA, d, N_EXPERTS), d ** -0.5),
        'moe_w_gate': nrm((N_GLA, N_EXPERTS, d, D_FF_EXPERT), d ** -0.5),
        'moe_w_up': nrm((N_GLA, N_EXPERTS, d, D_FF_EXPERT), d ** -0.5),
        'moe_w_down': nrm((N_GLA, N_EXPERTS, D_FF_EXPERT, d), D_FF_EXPERT ** -0.5),
    }


def reference(x, c, ctx, c_ctx, ada_w, ada_b, norm_mix_g, norm_ffn_g, final_g,
              ret_w_in, ret_log_decay, ret_gn_w, ret_gn_b, ret_w_out,
              gla_w_in, gla_w_gate_up, gla_b_gate, gla_norm_g, gla_w_out,
              ffn_w_gate, ffn_w_up, ffn_w_down,
              moe_w_router, moe_w_gate, moe_w_up, moe_w_down):
    lat, cx = x, ctx
    silu_c = jax.nn.silu(c)
    silu_cc = jax.nn.silu(c_ctx)
    for i in range(DEPTH):
        last = i == DEPTH - 1
        j = i // N_MIXERS
        mod_l = (silu_c @ ada_w[i] + ada_b[i])[:, None, :]
        mod_c = (silu_cc @ ada_w[i] + ada_b[i])[None, None, :]
        sh1_l, sc1_l, g1_l, sh2_l, sc2_l, g2_l = jnp.split(mod_l, 6, axis=-1)
        sh1_c, sc1_c, g1_c, sh2_c, sc2_c, g2_c = jnp.split(mod_c, 6, axis=-1)

        h_l = rmsnorm(lat, norm_mix_g[i]) * (1.0 + sc1_l) + sh1_l
        h_c = rmsnorm(cx, norm_mix_g[i]) * (1.0 + sc1_c) + sh1_c
        if i % N_MIXERS == 0:
            mix_l, mix_c = retention_mixer(h_c, h_l, ret_w_in[j], ret_log_decay[j], ret_gn_w[j],
                                           ret_gn_b[j], ret_w_out[j], not last)
        else:
            mix_l, mix_c = gla_mixer(h_c, h_l, gla_w_in[j], gla_w_gate_up[j], gla_b_gate[j],
                                     gla_norm_g[j], gla_w_out[j], not last)
        lat = lat + g1_l * mix_l.astype(lat.dtype)
        if not last:
            cx = cx + g1_c * mix_c.astype(cx.dtype)

        h_l = rmsnorm(lat, norm_ffn_g[i]) * (1.0 + sc2_l) + sh2_l
        if last:
            n_c = 0
            h_all = h_l
        else:
            n_c = cx.shape[1]
            h_c = rmsnorm(cx, norm_ffn_g[i]) * (1.0 + sc2_c) + sh2_c
            h_all = jnp.concatenate([h_c, h_l], axis=1)
        if i % 2 == 0:
            f = swiglu(h_all, ffn_w_gate[j], ffn_w_up[j], ffn_w_down[j])
        else:
            f = moe_swiglu(h_all, moe_w_router[j], moe_w_gate[j], moe_w_up[j], moe_w_down[j])
        lat = lat + g2_l * f[:, n_c:].astype(lat.dtype)
        if not last:
            cx = cx + g2_c * f[:, :n_c].astype(cx.dtype)
    return rmsnorm(lat, final_g)
```

```cpp
#include <hip/hip_runtime.h>
#include <cstdio>
#include <cstdint>
namespace pg8 {
#define PG8_LAS __attribute__((address_space(3)))
typedef unsigned short bf16_t;
typedef short bf16x8 __attribute__((ext_vector_type(8)));
typedef float f32x4 __attribute__((ext_vector_type(4)));
typedef unsigned u32x4 __attribute__((ext_vector_type(4)));
typedef int i32x4_t __attribute__((ext_vector_type(4)));
typedef int i32x8_t __attribute__((ext_vector_type(8)));
constexpr int BM = 256, BK = 64, HALF = 128, HTB = HALF * BK * 2  , STAGE_BYTES = 8 * HTB, NXCD = 8, WGM = 4;

__host__ __device__ __forceinline__ int lds_byte(int r, int c) { const int st = (r >> 4) * 2 + (c >> 5), rr = r & 15, cc = c & 31, ob = rr * 64 + cc * 2; return st * 1024 + (ob ^ (((ob >> 9) & 1) << 5)); }
__host__ __device__ __forceinline__ void stage_rc(int b, int& R, int& C) { const int st = b / 1024, sb = b % 1024, swz = sb ^ (((sb >> 9) & 1) << 5); R = (st >> 1) * 16 + swz / 64; C = (st & 1) * 32 + (swz % 64) / 2; }
__host__ __device__ __forceinline__ int perm32(int rho) { const int n = rho >> 4, i = rho & 15; return 8 * (i >> 2) + 4 * n + (i & 3); }

struct Unit { int pm, pn, pb, ks, koff, nt, fix, lim; };
struct Gemm { const bf16_t* A; const bf16_t* Bt; int M, N, K; unsigned sw, sx; const int* gidx; };

struct StaticOrder {
    int nM, nN, nwg, G, c, ntf;
    __host__ __device__ void init(int M, int N, int G_, int c_, int K_) { nM = M / BM; nN = N / BM; nwg = nM * nN; G = G_; c = c_; ntf = K_ / BK; }
    __host__ __device__ bool next(int i, Unit& u) const {
        const long L = (long)i * G + c; if (L >= nwg) return false;
        int wgid = (int)L; { const int q = nwg / NXCD, r = nwg % NXCD, xcd = wgid % NXCD, off = wgid / NXCD; wgid = (xcd < r ? xcd * (q + 1) : r * (q + 1) + (xcd - r) * q) + off; }
        const int nig = WGM * nN, gid = wgid / nig, fm = gid * WGM, gsz = (nM - fm) < WGM ? (nM - fm) : WGM;
        u.pm = fm + ((wgid % nig) % gsz); u.pn = (wgid % nig) / gsz; u.pb = u.pn; u.ks = 0; u.koff = 0; u.nt = ntf; u.fix = 0; u.lim = 0; return true;
    }
    __device__ __forceinline__ void a_ready(const Unit&) const {}
    __device__ __forceinline__ void done(const Unit&) const {}
};

__device__ __forceinline__ unsigned cvt_pk_bf16(float lo, float hi) { unsigned r; asm volatile("v_cvt_pk_bf16_f32 %0, %1, %2" : "=v"(r) : "v"(lo), "v"(hi)); return r; }
__device__ __forceinline__ u32x4 pack8(const f32x4 a, const f32x4 b) { u32x4 w; w.x = cvt_pk_bf16(a[0], a[1]); w.y = cvt_pk_bf16(a[2], a[3]); w.z = cvt_pk_bf16(b[0], b[1]); w.w = cvt_pk_bf16(b[2], b[3]); return w; }
__device__ __forceinline__ float silu_f(float x) { return x * __builtin_amdgcn_rcpf(1.0f + __builtin_amdgcn_exp2f(x * -1.4426950408889634f)); }

struct EpiRetIn {
    static constexpr bool PERM = true, AFTER_DRAIN = false;
    bf16_t* P; const float* ropec; const float* ropes;
    __device__ __forceinline__ void operator()(const f32x4 (&acc)[2][2][4][2], const Unit& u, int wr, int wc, int fr, int fq) const {
        const int pn = u.pn; const bool isq = pn < 4, isk = (pn >= 12 && pn < 16);
        const int cb = wc * 32 + 8 * fq;
        const float ksc = isk ? 0.0625f : 1.0f;
        const bool rot = (isq || isk) && (u.pm * BM >= 2048);
#pragma unroll
        for (int ai = 0; ai < 2; ++ai) {
            f32x4 cc[4][2], ss[4][2];
            if (rot) {
#pragma unroll
                for (int m = 0; m < 4; ++m) { const int row = u.pm * BM + ai * HALF + wr * 64 + m * 16 + fr; const int t = (row - 2048) & 2047; const int pos = (cb < 64) ? (t >> 6) : (t & 63); const int idx = cb & 63;
                    cc[m][0] = *(const f32x4*)(ropec + pos * 64 + idx); cc[m][1] = *(const f32x4*)(ropec + pos * 64 + idx + 4); ss[m][0] = *(const f32x4*)(ropes + pos * 64 + idx); ss[m][1] = *(const f32x4*)(ropes + pos * 64 + idx + 4); }
            }
#pragma unroll
            for (int m = 0; m < 4; ++m) {
                const int row = u.pm * BM + ai * HALF + wr * 64 + m * 16 + fr;
                f32x4 a0 = acc[ai][0][m][0], a1 = acc[ai][0][m][1], b0 = acc[ai][1][m][0], b1 = acc[ai][1][m][1];
                if (rot) {
                    const f32x4 c0 = cc[m][0] * ksc, s0 = ss[m][0] * ksc, c1 = cc[m][1] * ksc, s1 = ss[m][1] * ksc;
                    const f32x4 na0 = a0 * c0 - b0 * s0, nb0 = a0 * s0 + b0 * c0, na1 = a1 * c1 - b1 * s1, nb1 = a1 * s1 + b1 * c1; a0 = na0; b0 = nb0; a1 = na1; b1 = nb1;
                } else if (isk) { a0 = a0 * ksc; a1 = a1 * ksc; b0 = b0 * ksc; b1 = b1 * ksc; }
                bf16_t* rowp = P + (size_t)row * 6144 + pn * BM + cb;
                *(u32x4*)(rowp) = pack8(a0, a1); *(u32x4*)(rowp + HALF) = pack8(b0, b1);
            }
        }
    }
};
struct EpiGlaIn {
    static constexpr bool PERM = true, AFTER_DRAIN = false;
    bf16_t* P; float* AF;
    __device__ __forceinline__ void operator()(const f32x4 (&acc)[2][2][4][2], const Unit& u, int wr, int wc, int fr, int fq) const {
        const int pn = u.pn; const float sc = (pn < 2) ? 0.08838834764831845f : 1.0f;
        const int cb = wc * 32 + 8 * fq;
#pragma unroll
        for (int ai = 0; ai < 2; ++ai)
#pragma unroll
            for (int m = 0; m < 4; ++m) {
                const int row = u.pm * BM + ai * HALF + wr * 64 + m * 16 + fr;
                const f32x4 a0 = acc[ai][0][m][0] * sc, a1 = acc[ai][0][m][1] * sc, b0 = acc[ai][1][m][0] * sc, b1 = acc[ai][1][m][1] * sc;
                bf16_t* rowp = P + (size_t)row * 3328 + pn * BM + cb;
                *(u32x4*)(rowp) = pack8(a0, a1); *(u32x4*)(rowp + HALF) = pack8(b0, b1);
                if (pn == 12 && cb < 32) { float* ap = AF + (size_t)row * 32 + cb; *(f32x4*)ap = a0; *(f32x4*)(ap + 4) = a1; }
            }
    }
};
struct EpiResid {
    static constexpr bool PERM = true, AFTER_DRAIN = false;
    bf16_t* TOK; const float* rd; const float* rd_ctx; const float* gate; int row_off; bf16_t* PS; int ncp;
    __device__ __forceinline__ void operator()(const f32x4 (&acc)[2][2][4][2], const Unit& u, int wr, int wc, int fr, int fq) const {
        const int rt = row_off + u.pm * BM; const int col0 = u.pn * BM + wc * 32 + 8 * fq;
        if (u.pm < ncp) {
            bf16_t* pb = PS + ((size_t)u.ks * 2048 + rt) * 1024 + col0;
#pragma unroll
            for (int ai = 0; ai < 2; ++ai)
#pragma unroll
                for (int m = 0; m < 4; ++m) { bf16_t* rowp = pb + (size_t)(ai * HALF + wr * 64 + m * 16 + fr) * 1024;
#pragma unroll
                    for (int bj = 0; bj < 2; ++bj) *(u32x4*)(rowp + bj * HALF) = pack8(acc[ai][bj][m][0], acc[ai][bj][m][1]); }
            return;
        }
        const int s = (rt < 2048) ? 8 : ((rt - 2048) >> 11);
        const float* gp = gate + s * 6144 + col0; const float* rb = (rt < 2048) ? rd_ctx : rd;
        f32x4 gv[2][2];
#pragma unroll
        for (int bj = 0; bj < 2; ++bj)
#pragma unroll
            for (int n = 0; n < 2; ++n) gv[bj][n] = *(const f32x4*)(gp + bj * HALF + n * 4);
#pragma unroll
        for (int ai = 0; ai < 2; ++ai) {
            if (rb) {
                f32x4 o0[4][2], o1[4][2];
#pragma unroll
                for (int m = 0; m < 4; ++m)
#pragma unroll
                    for (int bj = 0; bj < 2; ++bj) { const size_t o = (size_t)(rt + ai * HALF + wr * 64 + m * 16 + fr) * 1024 + col0 + bj * HALF; o0[m][bj] = *(const f32x4*)(rb + o); o1[m][bj] = *(const f32x4*)(rb + o + 4); }
#pragma unroll
                for (int m = 0; m < 4; ++m)
#pragma unroll
                    for (int bj = 0; bj < 2; ++bj) { const size_t o = (size_t)(rt + ai * HALF + wr * 64 + m * 16 + fr) * 1024 + col0 + bj * HALF;
                        *(u32x4*)(TOK + o) = pack8(o0[m][bj] + gv[bj][0] * acc[ai][bj][m][0], o1[m][bj] + gv[bj][1] * acc[ai][bj][m][1]); }
            } else {
                u32x4 w[4][2];
#pragma unroll
                for (int m = 0; m < 4; ++m)
#pragma unroll
                    for (int bj = 0; bj < 2; ++bj) w[m][bj] = *(const u32x4*)(TOK + (size_t)(rt + ai * HALF + wr * 64 + m * 16 + fr) * 1024 + col0 + bj * HALF);
#pragma unroll
                for (int m = 0; m < 4; ++m)
#pragma unroll
                    for (int bj = 0; bj < 2; ++bj) { const size_t o = (size_t)(rt + ai * HALF + wr * 64 + m * 16 + fr) * 1024 + col0 + bj * HALF; const u32x4 ww = w[m][bj]; f32x4 o0, o1;
                        o0[0] = __uint_as_float(ww.x << 16); o0[1] = __uint_as_float(ww.x & 0xffff0000u); o0[2] = __uint_as_float(ww.y << 16); o0[3] = __uint_as_float(ww.y & 0xffff0000u);
                        o1[0] = __uint_as_float(ww.z << 16); o1[1] = __uint_as_float(ww.z & 0xffff0000u); o1[2] = __uint_as_float(ww.w << 16); o1[3] = __uint_as_float(ww.w & 0xffff0000u);
                        *(u32x4*)(TOK + o) = pack8(o0 + gv[bj][0] * acc[ai][bj][m][0], o1 + gv[bj][1] * acc[ai][bj][m][1]); }
            }
        }
    }
};
template <bool TWICE> __device__ __forceinline__ f32x4 swiglu4(const f32x4 g, const f32x4 u) {
    const f32x4 t = g * -1.4426950408889634f; f32x4 ex, r;
#pragma unroll
    for (int j = 0; j < 4; ++j) ex[j] = __builtin_amdgcn_exp2f(t[j]);
    const f32x4 d = TWICE ? ex * 0.5f + 0.5f : ex + 1.0f;
#pragma unroll
    for (int j = 0; j < 4; ++j) r[j] = __builtin_amdgcn_rcpf(d[j]);
    return (g * u) * r;
}
struct EpiSwiglu {
    static constexpr bool PERM = true, AFTER_DRAIN = false;
    bf16_t* H; int ldh;
    __device__ __forceinline__ void operator()(const f32x4 (&acc)[2][2][4][2], const Unit& u, int wr, int wc, int fr, int fq) const {
        const int cb = u.pn * HALF + wc * 32 + 8 * fq;
#pragma unroll
        for (int ai = 0; ai < 2; ++ai)
#pragma unroll
            for (int m = 0; m < 4; ++m) {
                const int row = u.pm * BM + ai * HALF + wr * 64 + m * 16 + fr;
                const f32x4 h0 = swiglu4<false>(acc[ai][0][m][0], acc[ai][1][m][0]), h1 = swiglu4<false>(acc[ai][0][m][1], acc[ai][1][m][1]);
                *(u32x4*)(H + (size_t)row * ldh + cb) = pack8(h0, h1);
            }
    }
};
__device__ __forceinline__ unsigned pack4_fp8(float a, float b, float c, float d) {
    int li_ = 0x43e00000; asm volatile("" : "+s"(li_)); const float lim = __builtin_bit_cast(float, li_);
    a = __builtin_amdgcn_fmed3f(a, -lim, lim); b = __builtin_amdgcn_fmed3f(b, -lim, lim); c = __builtin_amdgcn_fmed3f(c, -lim, lim); d = __builtin_amdgcn_fmed3f(d, -lim, lim);
    int w = 0; w = __builtin_amdgcn_cvt_pk_fp8_f32(a, b, w, false); w = __builtin_amdgcn_cvt_pk_fp8_f32(c, d, w, true); return (unsigned)w; }
struct EpiSwigluF8 {
    static constexpr bool PERM = true, AFTER_DRAIN = false;
    unsigned char* H; int ldh;
    __device__ __forceinline__ void operator()(const f32x4 (&acc)[2][2][4][2], const Unit& u, int wr, int wc, int fr, int fq) const {
        const int cb = u.pn * HALF + wc * 32 + 8 * fq;
#pragma unroll
        for (int ai = 0; ai < 2; ++ai)
#pragma unroll
            for (int m = 0; m < 4; ++m) {
                const int row = u.pm * BM + ai * HALF + wr * 64 + m * 16 + fr;
                const f32x4 h0 = swiglu4<true>(acc[ai][0][m][0], acc[ai][1][m][0]), h1 = swiglu4<true>(acc[ai][0][m][1], acc[ai][1][m][1]);
                typedef unsigned u32x2e __attribute__((ext_vector_type(2))); u32x2e o; o.x = pack4_fp8(h0[0], h0[1], h0[2], h0[3]); o.y = pack4_fp8(h1[0], h1[1], h1[2], h1[3]);
                *(u32x2e*)(H + (size_t)row * ldh + cb) = o;
            }
    }
};
struct EpiNull {
    static constexpr bool PERM = true, AFTER_DRAIN = false;
    __device__ __forceinline__ void operator()(const f32x4 (&acc)[2][2][4][2], const Unit& u, int wr, int wc, int fr, int fq) const {
#pragma unroll
        for (int ai = 0; ai < 2; ++ai)
#pragma unroll
            for (int m = 0; m < 4; ++m) asm volatile("" :: "v"(acc[ai][0][m][0]), "v"(acc[ai][0][m][1]), "v"(acc[ai][1][m][0]), "v"(acc[ai][1][m][1])); }
};
constexpr int MOE_KSPLIT_E = 1;
struct EpiMoeDown {
    static constexpr bool PERM = true, AFTER_DRAIN = false;
    bf16_t* YB; const int* rowinfo; const float* roww;
    __device__ __forceinline__ void operator()(const f32x4 (&acc)[2][2][4][2], const Unit& u, int wr, int wc, int fr, int fq) const {
        const int col0 = u.pn * BM + wc * 32 + 8 * fq;
        int info[8]; float w[8];
#pragma unroll
        for (int i = 0; i < 8; ++i) { const int p = (i >> 2) * HALF + wr * 64 + (i & 3) * 16 + fr, R = u.pm * BM + p + u.fix; const bool ok = p < u.lim; info[i] = ok ? rowinfo[R] : -1; w[i] = ok ? roww[R] : 0.f; }
#pragma unroll
        for (int ai = 0; ai < 2; ++ai)
#pragma unroll
            for (int m = 0; m < 4; ++m) { const int i = ai * 4 + m;
                if (info[i] >= 0) { bf16_t* rowp = YB + ((size_t)info[i] * MOE_KSPLIT_E + u.ks) * 1024 + col0;
#pragma unroll
                    for (int bj = 0; bj < 2; ++bj) *(u32x4*)(rowp + bj * HALF) = pack8(acc[ai][bj][m][0] * w[i], acc[ai][bj][m][1] * w[i]); } }
    }
};
struct MoeOrder {
    int nM, nN, nwg, G, c, nsplit, ntf; int poff[9]; int cnt[8]; int cap;
    __device__ __forceinline__ bool next(int i, Unit& u) const {
        const long L = (long)i * G + c; if (L >= nwg) return false;
        int wgid = (int)L; { const int q = nwg / NXCD, r = nwg % NXCD, xcd = wgid % NXCD, off = wgid / NXCD; wgid = (xcd < r ? xcd * (q + 1) : r * (q + 1) + (xcd - r) * q) + off; }
        const int nNv = nN * nsplit, nig = WGM * nNv, gid = wgid / nig, fm = gid * WGM, gsz = (nM - fm) < WGM ? (nM - fm) : WGM;
        u.pm = fm + ((wgid % nig) % gsz); const int pv = (wgid % nig) / gsz; u.pn = pv / nsplit; u.ks = pv % nsplit; u.nt = ntf / nsplit; u.koff = u.ks * u.nt * BK;
        int e = 0, pe = 0, ce = 0;
#pragma unroll
        for (int k = 1; k < 8; ++k) e += (u.pm >= poff[k]) ? 1 : 0;
#pragma unroll
        for (int k = 0; k < 8; ++k) { pe += (e == k) ? poff[k] : 0; ce += (e == k) ? cnt[k] : 0; }
        u.pb = e * nN + u.pn; u.fix = e * cap - pe * BM; u.lim = ce - (u.pm - pe) * BM; return true;
    }
    __device__ __forceinline__ void a_ready(const Unit&) const {}
    __device__ __forceinline__ void done(const Unit&) const {}
};


struct ResidOrder {
    StaticOrder so; int ncp, nsub, S, pairs;
    __device__ __forceinline__ void init(int M, int N, int G_, int c_, int K_, int ncp_, int S_) { ncp = ncp_; S = S_; pairs = K_ / 128; so.init(M - ncp_ * BM, N, G_, c_, K_); nsub = ncp_ * (N / BM) * S_; }
    __device__ __forceinline__ bool next(int i, Unit& u) const {
        if (so.next(i, u)) { u.pm += ncp; return true; }
        const long Ls = (long)i * so.G + so.c - so.nwg; if (Ls >= nsub) return false;
        const int ks = (int)(Ls % S), r = (int)(Ls / S); u.pn = r % so.nN; u.pm = r / so.nN; u.pb = u.pn; u.ks = ks; u.fix = 0; u.lim = 0;
        const int base = pairs / S, rem = pairs % S; const int start = ks < rem ? ks * (base + 1) : rem * (base + 1) + (ks - rem) * base;
        u.koff = 128 * start; u.nt = 2 * (base + (ks < rem ? 1 : 0)); return true;
    }
    __device__ __forceinline__ void a_ready(const Unit&) const {}
    __device__ __forceinline__ void done(const Unit&) const {}
};

template <class Epi, class Sched, bool ALIGN_EPI = false, bool SP2 = false, bool FP8 = false, bool GATHER = false>
__device__ __forceinline__ void gemm_phase(PG8_LAS unsigned char* lds, const Gemm g, const Sched& S, const Epi& E, int tid_) {
    const int tid = tid_, wid = __builtin_amdgcn_readfirstlane(tid >> 6), lane = tid & 63, wr = wid >> 2, wc = wid & 3, fr = lane & 15, fq = lane >> 4;
    int sw_v = (int)g.sw, sx_v = (int)g.sx;
    if constexpr (FP8) { int s0_ = sw_v, s1_ = sx_v; asm volatile("" : "+s"(s0_), "+s"(s1_)); sw_v = s0_; sx_v = s1_; }
    const int K = g.K;
    unsigned voffA[2], voffB[2];
#pragma unroll
    for (int i = 0; i < 2; ++i) { int R, C; stage_rc(tid * 16 + i * 8192, R, C); const int Rb = Epi::PERM ? ((R & ~31) + perm32(R & 31)) : R;
        voffA[i] = (unsigned)(R * K + C) * 2u; voffB[i] = (unsigned)(Rb * K + C) * 2u; }
    const size_t kstep = (size_t)(BK * 2);
    const size_t hstep = (size_t)HALF * K * 2;
    const size_t tstep = 2 * hstep;
    const unsigned ldsw = (unsigned)wid * 1024u;
    const int aoff = lds_byte(wr * 64 + fr, fq * 8), boff = lds_byte(wc * 32 + fr, fq * 8);
#define PG8_SA(b, h) (((b) * 2 + (h)) * HTB)
#define PG8_SB(b, h) ((4 + (b) * 2 + (h)) * HTB)
#define PG8_STAGE(bufoff, gbase, voff) do { _Pragma("unroll") for (int _i = 0; _i < 2; ++_i) \
        __builtin_amdgcn_global_load_lds((const unsigned*)((const char*)(gbase) + (voff)[_i]), (PG8_LAS unsigned*)(lds + (bufoff) + ldsw + _i * 8192), 16, 0, 0); } while (0)
#define PG8_STA(bufoff, base, h, OFF) do { if constexpr (GATHER) PG8_STAGE(bufoff, base, OFF[h]); else PG8_STAGE(bufoff, (base) + (h) * hstep, voffA); } while (0)
#define PG8_GLOAD(dst, U) do { _Pragma("unroll") for (int h_ = 0; h_ < 2; ++h_) _Pragma("unroll") for (int i_ = 0; i_ < 2; ++i_) { int R_, C_; stage_rc(tid * 16 + i_ * 8192, R_, C_); const int p_ = h_ * HALF + R_; \
        dst[h_][i_] = (p_ < (U).lim) ? g.gidx[(U).pm * BM + p_ + (U).fix] : 0; } } while (0)
#define PG8_GOFF(dst, raw) do { _Pragma("unroll") for (int h_ = 0; h_ < 2; ++h_) _Pragma("unroll") for (int i_ = 0; i_ < 2; ++i_) { int R_, C_; stage_rc(tid * 16 + i_ * 8192, R_, C_); \
        dst[h_][i_] = ((unsigned)(raw[h_][i_] >> 1) * (unsigned)K + (unsigned)C_) * 2u; } } while (0)
#define PG8_LDA(dst, b, h) do { _Pragma("unroll") for (int m = 0; m < 4; ++m) _Pragma("unroll") for (int k = 0; k < 2; ++k) dst[m][k] = *(const PG8_LAS bf16x8*)(lds + PG8_SA(b, h) + aoff + m * 2048 + k * 1024); } while (0)
#define PG8_LDB(dst, b, h) do { _Pragma("unroll") for (int n = 0; n < 2; ++n) _Pragma("unroll") for (int k = 0; k < 2; ++k) dst[n][k] = *(const PG8_LAS bf16x8*)(lds + PG8_SB(b, h) + boff + n * 2048 + k * 1024); } while (0)
#define PG8_CAT(x, y) __builtin_shufflevector(__builtin_bit_cast(i32x4_t, (x)), __builtin_bit_cast(i32x4_t, (y)), 0, 1, 2, 3, 4, 5, 6, 7)
#define PG8_MMA(ai, bj, At, Bt) do { __builtin_amdgcn_s_setprio(1); _Pragma("unroll") for (int m = 0; m < 4; ++m) _Pragma("unroll") for (int n = 0; n < 2; ++n) { \
        if constexpr (FP8) { const i32x8_t a8_ = PG8_CAT(Bt[n][0], Bt[n][1]), b8_ = PG8_CAT(At[m][0], At[m][1]);     \
            asm volatile("v_mfma_scale_f32_16x16x128_f8f6f4 %0, %1, %2, %0, %3, %4 op_sel_hi:[0,0,0]" : "+v"(acc[ai][bj][m][n]) : "v"(a8_), "v"(b8_), "v"(sw_v), "v"(sx_v)); } \
        else { _Pragma("unroll") for (int k = 0; k < 2; ++k) acc[ai][bj][m][n] = __builtin_amdgcn_mfma_f32_16x16x32_bf16(Bt[n][k], At[m][k], acc[ai][bj][m][n], 0, 0, 0); } } __builtin_amdgcn_s_setprio(0); } while (0)
#define PG8_WAIT_V(n) asm volatile("s_waitcnt vmcnt(" #n ")" ::: "memory")
#define PG8_WAIT_L(n) asm volatile("s_waitcnt lgkmcnt(" #n ")" ::: "memory")
#define PG8_BAR __builtin_amdgcn_s_barrier()
#define PG8_SCHED __builtin_amdgcn_sched_barrier(0)
    Unit cur, nxt, nn; int ui = 0;
    if (!S.next(0, cur)) return;
    unsigned cv[2][2], nv[2][2], sel[2][2]; int raw[2][2];
    f32x4 acc[2][2][4][2];
#pragma unroll
    for (int a = 0; a < 2; ++a)
#pragma unroll
        for (int b = 0; b < 2; ++b)
#pragma unroll
            for (int m = 0; m < 4; ++m)
#pragma unroll
                for (int n = 0; n < 2; ++n) acc[a][b][m][n] = (f32x4){0.f, 0.f, 0.f, 0.f};
    bf16x8 At[4][2], B0[2][2], B1[2][2];
    const char* cA = (const char*)g.A + (GATHER ? (size_t)0 : (size_t)cur.pm * tstep) + (size_t)cur.koff * 2; const char* cB = (const char*)g.Bt + (size_t)cur.pb * tstep + (size_t)cur.koff * 2;
    S.a_ready(cur);
    if constexpr (GATHER) { PG8_GLOAD(raw, cur); PG8_GOFF(cv, raw);
        if (S.next(1, nxt)) { PG8_GLOAD(raw, nxt); PG8_GOFF(nv, raw); } else { _Pragma("unroll") for (int h_ = 0; h_ < 2; ++h_) _Pragma("unroll") for (int i_ = 0; i_ < 2; ++i_) nv[h_][i_] = cv[h_][i_]; } }
    if constexpr (SP2) {
        PG8_STAGE(PG8_SB(0, 0), cB, voffB); PG8_STAGE(PG8_SB(0, 1), cB + hstep, voffB); PG8_STA(PG8_SA(0, 0), cA, 0, cv); PG8_STA(PG8_SA(0, 1), cA, 1, cv);
        if (wr == 1) PG8_BAR;
        PG8_WAIT_V(2); PG8_BAR;
        PG8_STAGE(PG8_SB(1, 0), cB + kstep, voffB); PG8_STA(PG8_SA(1, 0), cA + kstep, 0, cv); PG8_STAGE(PG8_SB(1, 1), cB + hstep + kstep, voffB);
        PG8_WAIT_V(6); PG8_BAR;
    } else {
        PG8_STAGE(PG8_SB(0, 0), cB, voffB); PG8_STAGE(PG8_SA(0, 0), cA, voffA); PG8_STAGE(PG8_SB(0, 1), cB + hstep, voffB); PG8_STAGE(PG8_SA(0, 1), cA + hstep, voffA);
        if (wr == 1) PG8_BAR;
        PG8_WAIT_V(4); PG8_BAR;
        PG8_STAGE(PG8_SB(1, 0), cB + kstep, voffB); PG8_STAGE(PG8_SA(1, 0), cA + kstep, voffA); PG8_STAGE(PG8_SB(1, 1), cB + hstep + kstep, voffB);
        PG8_WAIT_V(6); PG8_BAR;
    }
    for (;;) {
        const bool has_next = S.next(ui + 1, nxt);
        const char* nA = has_next ? (const char*)g.A + (GATHER ? (size_t)0 : (size_t)nxt.pm * tstep) + (size_t)nxt.koff * 2 : cA; const char* nB = has_next ? (const char*)g.Bt + (size_t)nxt.pb * tstep + (size_t)nxt.koff * 2 : cB;
        const int nt = cur.nt;
        for (int t = 0; t < nt; t += 2) {
            const bool last = (t == nt - 2);
            const char* a1 = cA + (size_t)(t + 1) * kstep;
            const char* a2 = last ? nA : cA + (size_t)(t + 2) * kstep; const char* b2 = last ? nB : cB + (size_t)(t + 2) * kstep;
            const char* a3 = a2 + kstep; const char* b3 = b2 + kstep;
            if (last && has_next) S.a_ready(nxt);
            if constexpr (GATHER) { _Pragma("unroll") for (int h_ = 0; h_ < 2; ++h_) _Pragma("unroll") for (int i_ = 0; i_ < 2; ++i_) sel[h_][i_] = last ? nv[h_][i_] : cv[h_][i_]; }
            if constexpr (SP2) {
            PG8_LDB(B0, 0, 0); PG8_LDB(B1, 0, 1); PG8_SCHED; PG8_LDA(At, 0, 0); PG8_STA(PG8_SA(1, 1), a1, 1, cv);
            PG8_WAIT_V(8); PG8_WAIT_L(0); PG8_BAR; PG8_MMA(0, 0, At, B0); PG8_MMA(0, 1, At, B1); PG8_BAR; PG8_SCHED;
            PG8_LDA(At, 0, 1); PG8_STAGE(PG8_SB(0, 0), b2, voffB); PG8_STAGE(PG8_SB(0, 1), b2 + hstep, voffB); PG8_STA(PG8_SA(0, 0), a2, 0, sel);
            PG8_WAIT_V(8); PG8_WAIT_L(0); PG8_BAR; PG8_MMA(1, 0, At, B0); PG8_MMA(1, 1, At, B1); PG8_BAR; PG8_SCHED;
            PG8_LDB(B0, 1, 0); PG8_LDB(B1, 1, 1); PG8_SCHED; PG8_LDA(At, 1, 0); PG8_STA(PG8_SA(0, 1), a2, 1, sel);
            PG8_WAIT_V(8); PG8_WAIT_L(0); PG8_BAR; PG8_MMA(0, 0, At, B0); PG8_MMA(0, 1, At, B1); PG8_BAR; PG8_SCHED;
            PG8_LDA(At, 1, 1); PG8_STAGE(PG8_SB(1, 0), b3, voffB); PG8_STAGE(PG8_SB(1, 1), b3 + hstep, voffB); PG8_STA(PG8_SA(1, 0), a3, 0, sel);
            PG8_WAIT_V(8); PG8_WAIT_L(0); PG8_BAR; PG8_MMA(1, 0, At, B0); PG8_MMA(1, 1, At, B1); PG8_BAR; PG8_SCHED;
            } else {
            PG8_LDB(B0, 0, 0); PG8_SCHED; PG8_LDA(At, 0, 0); PG8_STAGE(PG8_SA(1, 1), a1 + hstep, voffA);
            PG8_WAIT_L(8); PG8_BAR; PG8_WAIT_L(0); PG8_MMA(0, 0, At, B0); PG8_BAR; PG8_SCHED;
            PG8_LDB(B1, 0, 1); PG8_STAGE(PG8_SB(0, 0), b2, voffB);
            PG8_BAR; PG8_WAIT_L(0); PG8_MMA(0, 1, At, B1); PG8_BAR;
            PG8_LDA(At, 0, 1); PG8_STAGE(PG8_SA(0, 0), a2, voffA);
            PG8_BAR; PG8_WAIT_L(0); PG8_MMA(1, 0, At, B0); PG8_BAR; PG8_SCHED;
            PG8_STAGE(PG8_SB(0, 1), b2 + hstep, voffB);
            PG8_WAIT_V(6); PG8_BAR; PG8_MMA(1, 1, At, B1); PG8_BAR;
            PG8_LDB(B0, 1, 0); PG8_SCHED; PG8_LDA(At, 1, 0); PG8_STAGE(PG8_SA(0, 1), a2 + hstep, voffA);
            PG8_WAIT_L(8); PG8_BAR; PG8_WAIT_L(0); PG8_MMA(0, 0, At, B0); PG8_BAR; PG8_SCHED;
            PG8_LDB(B1, 1, 1); PG8_STAGE(PG8_SB(1, 0), b3, voffB);
            PG8_BAR; PG8_WAIT_L(0); PG8_MMA(0, 1, At, B1); PG8_BAR;
            PG8_LDA(At, 1, 1); PG8_STAGE(PG8_SA(1, 0), a3, voffA);
            PG8_BAR; PG8_WAIT_L(0); PG8_MMA(1, 0, At, B0); PG8_BAR; PG8_SCHED;
            PG8_STAGE(PG8_SB(1, 1), b3 + hstep, voffB);
            PG8_WAIT_V(6); PG8_BAR; PG8_MMA(1, 1, At, B1); PG8_BAR;
            }
        }
        if constexpr (ALIGN_EPI) { if (wr == 0) PG8_BAR; }
        bool has_nn = false;
        if constexpr (GATHER) { static_assert(SP2, "GATHER is written for the SP2 loop"); has_nn = has_next && S.next(ui + 2, nn); if (has_nn) PG8_GLOAD(raw, nn); }
        if constexpr (FP8) asm volatile("s_nop 15\n\ts_nop 15" ::: "memory");
        if constexpr (!Epi::AFTER_DRAIN) { int tz = tid; asm volatile("" : "+v"(tz));
            const int lz = tz & 63, wz = __builtin_amdgcn_readfirstlane(tz >> 6); E(acc, cur, wz >> 2, wz & 3, lz & 15, lz >> 4); S.done(cur); }
        if (!has_next) break;
#pragma unroll
        for (int a = 0; a < 2; ++a)
#pragma unroll
            for (int b = 0; b < 2; ++b)
#pragma unroll
                for (int m = 0; m < 4; ++m)
#pragma unroll
                    for (int n = 0; n < 2; ++n) acc[a][b][m][n] = (f32x4){0.f, 0.f, 0.f, 0.f};
        cur = nxt; cA = nA; cB = nB; ++ui;
        if constexpr (GATHER) { _Pragma("unroll") for (int h_ = 0; h_ < 2; ++h_) _Pragma("unroll") for (int i_ = 0; i_ < 2; ++i_) cv[h_][i_] = nv[h_][i_];
            if (has_nn) PG8_GOFF(nv, raw); }
        if constexpr (ALIGN_EPI) { if (wr == 1) PG8_BAR; }
    }
    PG8_WAIT_V(0);
    if constexpr (!ALIGN_EPI) { if (wr == 0) PG8_BAR; }
    PG8_BAR;
    if constexpr (Epi::AFTER_DRAIN) { E.fused(acc, cur, wr, wc, fr, fq, lds, wid, lane); S.done(cur); }
#undef PG8_SA
#undef PG8_SB
#undef PG8_STAGE
#undef PG8_LDA
#undef PG8_STA
#undef PG8_GLOAD
#undef PG8_GOFF
#undef PG8_LDB
#undef PG8_MMA
#undef PG8_CAT
#undef PG8_WAIT_V
#undef PG8_WAIT_L
#undef PG8_BAR
#undef PG8_SCHED
}
}

constexpr int NWAVES = 8;
constexpr int D = 1024, NB = 8, SEQ = 2048, CTXL = 256, DEPTH = 4;
constexpr int NCTX = NB * CTXL, NLAT = NB * SEQ, NTOK = NCTX + NLAT;
constexpr int RET_IN = 6144, GLA_IN = 3104, GLA_INP = 3328, DFF = 2816, NE = 8, DFFE = 3584;
constexpr int MAXROWS = 2 * NTOK + NE * 256;
constexpr float EPS = 1e-6f;
constexpr int MOE_KSPLIT = 1;

constexpr size_t MiB = 1u << 20;
constexpr size_t WS_CTL = 0, CTL_ZERO_BYTES = 1 * MiB;
constexpr size_t WS_MODS = 1 * MiB;
constexpr size_t WS_ROPE = 2 * MiB;
constexpr size_t WS_TIE = 3 * MiB, WS_TIP0 = WS_TIE + 128 * 1024, WS_TIP1 = WS_TIE + 256 * 1024, WS_TIW = WS_TIE + 384 * 1024;
constexpr size_t WS_RINFO = WS_TIE, WS_RW = 7 * MiB;
constexpr size_t WS_AF = 4 * MiB;
constexpr size_t WS_TOK = 8 * MiB;
constexpr size_t WS_HA = 80 * MiB;
constexpr size_t WS_WRET = 116 * MiB;
constexpr size_t WR_IN = 0, WR_OUT = 12 * MiB, WR_GU = 16 * MiB, WR_DN = 27 * MiB;
constexpr size_t WS_WGLA = 150 * MiB;
constexpr size_t WG_IN = 0, WG_OUT = 7 * MiB, WG_GU = 9 * MiB, WG_DN = 121 * MiB;
constexpr size_t WS_SCR = 328 * MiB;
constexpr size_t WS_P = WS_SCR, WS_OF = WS_SCR + 216 * MiB, WS_OB = WS_SCR + 288 * MiB, WS_A2 = WS_SCR + 360 * MiB;
constexpr size_t WS_QT = WS_SCR + 120 * MiB, WS_EB = WS_SCR + 192 * MiB;
constexpr size_t WS_HID = WS_SCR;
constexpr size_t WS_HIDG = WS_SCR, WS_AG = WS_SCR + 272 * MiB, WS_YB = WS_SCR + 360 * MiB;
constexpr size_t WS_PS = WS_SCR + 216 * MiB;
constexpr size_t WS_END = WS_YB + (size_t)144 * MOE_KSPLIT * MiB;
static_assert(WS_HIDG + (size_t)MAXROWS * DFFE * 2 <= WS_AG && WS_AG + (size_t)MAXROWS * D * 2 <= WS_YB, "MoE scratch map");
static_assert(WS_P + (size_t)NTOK * RET_IN * 2 <= WS_OF && WS_OF + (size_t)NTOK * 2048 * 2 <= WS_OB && WS_OB + (size_t)NTOK * 2048 * 2 <= WS_A2, "scratch map");
constexpr int CW_TMO = 0, CW_CODE = 1, CW_BAR = 4096, CW_GCNT = 8192, CW_CVTQ = 9216;

constexpr int LDS_BYTES = 147456;
constexpr int MISC_OFF = 147456 - 256;

#define GAS __attribute__((address_space(1)))
#define LAS __attribute__((address_space(3)))
#define DI __device__ __forceinline__
typedef unsigned short bf16;
typedef float f32x4 __attribute__((ext_vector_type(4)));
typedef float f32x2 __attribute__((ext_vector_type(2)));
typedef unsigned u32x4 __attribute__((ext_vector_type(4)));
typedef unsigned u32x2 __attribute__((ext_vector_type(2)));
#define LDS_WAIT() asm volatile("s_waitcnt lgkmcnt(0)" ::: "memory")
#define VM_WAIT() asm volatile("s_waitcnt vmcnt(0)" ::: "memory")
DI float bf_lo(unsigned w) { return __uint_as_float(w << 16); }
DI float bf_hi(unsigned w) { return __uint_as_float(w & 0xffff0000u); }
DI unsigned pk2(float lo, float hi) { return pg8::cvt_pk_bf16(lo, hi); }
DI float wave_sum(float v, int  ) {
#define WS_DPP(ctrl, rmask) v += __builtin_bit_cast(float, __builtin_amdgcn_update_dpp(0, __builtin_bit_cast(int, v), ctrl, rmask, 0xF, false))
    WS_DPP(0xB1, 0xF); WS_DPP(0x4E, 0xF); WS_DPP(0x141, 0xF); WS_DPP(0x140, 0xF); WS_DPP(0x142, 0xA); WS_DPP(0x143, 0xC);
#undef WS_DPP
    return __builtin_bit_cast(float, __builtin_amdgcn_readlane(__builtin_bit_cast(int, v), 63));
}
DI float silu(float x) { return x * __builtin_amdgcn_rcpf(1.0f + __builtin_amdgcn_exp2f(x * -1.4426950408889634f)); }

#define XB_TMO      128
#define XB_XCNT(j)  (256  + 64 * (j))
#define XB_XSUB(j)  (1280 + 64 * (j))
#define XB_XGEN(j)  (2304 + 64 * (j))
#define XB_TOP      3328
#define XB_TOPGEN   3392
#define XCD_BAR_WORDS 3456
#define XB_SPIN_CAP (1u << 18)

__device__ __forceinline__ unsigned xb_ld(unsigned* p)              { return __hip_atomic_load(p, __ATOMIC_RELAXED, __HIP_MEMORY_SCOPE_AGENT); }
__device__ __forceinline__ unsigned xb_add(unsigned* p, unsigned v) { return __hip_atomic_fetch_add(p, v, __ATOMIC_RELAXED, __HIP_MEMORY_SCOPE_AGENT); }
__device__ __forceinline__ unsigned xb_xcc_id() { return (unsigned)__builtin_amdgcn_s_getreg((3 << 11) | 20) & 0xFu; }
#define XB_SPIN(cond, bar) do { unsigned _sp = 0; while (cond) { __builtin_amdgcn_s_sleep(1); \
    if ((++_sp & 255u) == 0u) { if (xb_ld(&(bar)[XB_TMO])) break; if (_sp > XB_SPIN_CAP) { atomicAdd(&(bar)[XB_TMO], 1u); break; } } } } while (0)

struct XcdBarrier {
    unsigned* bar; unsigned x;
    volatile LAS unsigned* st;
};

__device__ __forceinline__ XcdBarrier xcd_barrier_post(unsigned* bar, volatile LAS unsigned* st) {
    XcdBarrier b; b.bar = bar; b.x = xb_xcc_id(); b.st = st;
    if (threadIdx.x == 0) (void)xb_add(&bar[XB_XCNT(b.x)], 1u);
    return b;
}
__device__ __forceinline__ void xcd_barrier_complete(unsigned* bar, unsigned x, unsigned& nloc, unsigned& nx) {
    const unsigned G = gridDim.x * gridDim.y * gridDim.z;
    unsigned sum, cnt, mine, sp = 0u;
    for (;;) {
        sum = 0u; cnt = 0u; mine = 0u;
#pragma unroll
        for (unsigned j = 0; j < 16; ++j) { const unsigned c = xb_ld(&bar[XB_XCNT(j)]); sum += c; cnt += (c > 0u) ? 1u : 0u; mine = (j == x) ? c : mine; }
        if (sum == G) break;
        __builtin_amdgcn_s_sleep(1);
        if ((++sp & 255u) == 0u) { if (xb_ld(&bar[XB_TMO])) break; if (sp > XB_SPIN_CAP) { atomicAdd(&bar[XB_TMO], 1u); break; } }
    }
    nloc = mine > 0u ? mine : 1u; nx = cnt > 0u ? cnt : 1u;
}

__device__ __forceinline__ void xcd_barrier(const XcdBarrier& b) {
    asm volatile("s_waitcnt vmcnt(0)" ::: "memory");
    __syncthreads();
    if (threadIdx.x == 0) {
        unsigned* bar = b.bar;
        __builtin_amdgcn_s_waitcnt(0);
        unsigned nloc = b.st[0], nx = b.st[1];
        if (nloc == 0u) { xcd_barrier_complete(bar, b.x, nloc, nx); b.st[0] = nloc; b.st[1] = nx; }
        const unsigned old = xb_add(&bar[XB_XSUB(b.x)], 1u);
        const unsigned gen = old / nloc;
        if (old + 1u == (gen + 1u) * nloc) {
            __builtin_amdgcn_fence(__ATOMIC_RELEASE, "agent");
            asm volatile("s_waitcnt vmcnt(0)" ::: "memory");
            const unsigned og = xb_add(&bar[XB_TOP], 1u);
            const unsigned tg = og / nx;
            if (og + 1u == (tg + 1u) * nx) xb_add(&bar[XB_TOPGEN], 1u);
            else XB_SPIN(xb_ld(&bar[XB_TOPGEN]) == tg, bar);
            __builtin_amdgcn_fence(__ATOMIC_ACQUIRE, "agent");
            xb_add(&bar[XB_XGEN(b.x)], 1u);
            asm volatile("s_waitcnt vmcnt(0)" ::: "memory");
        } else {
            XB_SPIN(xb_ld(&bar[XB_XGEN(b.x)]) == gen, bar);
            __builtin_amdgcn_fence(__ATOMIC_ACQUIRE, "agent");
            asm volatile("s_waitcnt vmcnt(0)" ::: "memory");
        }
    }
    __syncthreads();
}

struct Args { const float* in[26]; float* out; unsigned char* ws; int lo, hi; };
struct Frame {
    LAS unsigned char* lds;
    int tid, lane, wave, G, gw, NGW;
    unsigned char* ws;
    const __attribute__((address_space(4))) struct Args* ap;
    float* out;
};
enum { I_X = 0, I_C, I_CTX, I_CCTX, I_ADAW, I_ADAB, I_NMIX, I_NFFN, I_FING, I_RWIN, I_RDEC, I_RGNW, I_RGNB, I_RWOUT, I_GWIN, I_GWUP, I_GBG, I_GNG, I_GWOUT,
       I_FWG, I_FWU, I_FWD, I_MWR, I_MWG, I_MWU, I_MWD };

struct Src { const float* p; int ld; int nvalid; };
DI void cvt_tile(Frame& F, const Src s, int k0, bf16* dst  , int K, LAS unsigned* scr) {
    const int lane = F.lane;
    float v[64];
    const bool ok = lane < s.nvalid;
    const float* p = s.p + (size_t)k0 * s.ld + (ok ? lane : 0);
#pragma unroll
    for (int i = 0; i < 64; ++i) v[i] = __builtin_nontemporal_load(p + (size_t)i * s.ld);
#pragma unroll
    for (int i = 0; i < 64; ++i) v[i] = ok ? v[i] : 0.f;
#pragma unroll
    for (int i = 0; i < 32; ++i) scr[lane * 33 + i] = pk2(v[2 * i], v[2 * i + 1]);
    LDS_WAIT();
#pragma unroll
    for (int j = 0; j < 8; ++j) { const int n = (lane >> 3) + 8 * j, c = lane & 7; const LAS unsigned* q = scr + n * 33 + 4 * c;
        u32x4 o; o.x = q[0]; o.y = q[1]; o.z = q[2]; o.w = q[3];
        *(u32x4*)(dst + (size_t)n * K + k0 + 8 * c) = o; }
    LDS_WAIT();
}
DI void cvt_tile_f8(Frame& F, const Src s, int k0, unsigned char* dst, int Kb, float scale, LAS unsigned* scr) {
    const int lane = F.lane;
    float v[64];
    const bool ok = lane < s.nvalid;
    const float* p = s.p + (size_t)k0 * s.ld + (ok ? lane : 0);
#pragma unroll
    for (int i = 0; i < 64; ++i) v[i] = __builtin_nontemporal_load(p + (size_t)i * s.ld);
#pragma unroll
    for (int i = 0; i < 64; ++i) v[i] = ok ? v[i] * scale : 0.f;
#pragma unroll
    for (int i = 0; i < 16; ++i) scr[lane * 17 + i] = pg8::pack4_fp8(v[4 * i], v[4 * i + 1], v[4 * i + 2], v[4 * i + 3]);
    LDS_WAIT();
#pragma unroll
    for (int j = 0; j < 4; ++j) { const int n = (lane >> 2) + 16 * j, c = lane & 3; const LAS unsigned* q = scr + n * 17 + 4 * c;
        u32x4 o; o.x = q[0]; o.y = q[1]; o.z = q[2]; o.w = q[3];
        __builtin_nontemporal_store(o, (u32x4*)(dst + (size_t)n * Kb + k0 + 16 * c)); }
    LDS_WAIT();
}
DI int ret_qk_src_col(int n0) { const int blk = (n0 & 255) >> 6; const int sblk = (blk == 1) ? 2 : (blk == 2 ? 1 : blk); return (n0 & ~255) + sblk * 64; }
#ifndef CVT_FILL_WAVES
#define CVT_FILL_WAVES 0
#endif
constexpr float MOE_WGU_SCALE = 64.f, MOE_WDN_SCALE = 128.f;
constexpr unsigned E8M0_1 = 0x7f7f7f7fu, E8M0_2M1 = 0x7e7e7e7eu, E8M0_2M6 = 0x79797979u, E8M0_2M7 = 0x78787878u;
constexpr int CVT_RET_ITEMS = 16 * 96 + 32 * 16 + 16 * 88 + 44 * 16, CVT_GLA_ITEMS = 16 * 52 + 16 * 16 + 8 * 16 * 112 + 8 * 56 * 16;
DI void cvt_ret_item(Frame& F, int j, int r, LAS unsigned* scr) {
    bf16* W = (bf16*)(F.ws + WS_WRET);
    constexpr int I0 = 16 * 96, I1 = 32 * 16, I2 = 16 * 88;
    if (r < I0) { const int kt = r / 96, n0 = (r % 96) * 64; const int col = (n0 < 1024 || (n0 >= 3072 && n0 < 4096)) ? ret_qk_src_col(n0) : n0;
        cvt_tile(F, Src{F.ap->in[I_RWIN] + (size_t)j * 1024 * 6144 + col, 6144, 64}, kt * 64, W + WR_IN / 2 + (size_t)n0 * 1024, 1024, scr); return; } r -= I0;
    if (r < I1) { const int kt = r / 16, n0 = (r % 16) * 64;
        cvt_tile(F, Src{F.ap->in[I_RWOUT] + (size_t)j * 2048 * 1024 + n0, 1024, 64}, kt * 64, W + WR_OUT / 2 + (size_t)n0 * 2048, 2048, scr); return; } r -= I1;
    if (r < I2) { const int kt = r / 88, n0 = (r % 88) * 64; const int pn = n0 >> 8, p = n0 & 255, bj = p >> 7, rr = p & 127;
        const float* base = bj ? F.ap->in[I_FWU] : F.ap->in[I_FWG];
        cvt_tile(F, Src{base + (size_t)j * 1024 * 2816 + 128 * pn + rr, 2816, 64}, kt * 64, W + WR_GU / 2 + (size_t)n0 * 1024, 1024, scr); return; } r -= I2;
    { const int kt = r / 16, n0 = (r % 16) * 64;
        cvt_tile_f8(F, Src{F.ap->in[I_FWD] + (size_t)j * 2816 * 1024 + n0, 1024, 64}, kt * 64, (unsigned char*)(F.ws + WS_WRET) + WR_DN + (size_t)n0 * 2816, 2816, MOE_WDN_SCALE, scr); }
}
DI void cvt_gla_item(Frame& F, int j, int r, LAS unsigned* scr) {
    bf16* W = (bf16*)(F.ws + WS_WGLA);
    constexpr int I0 = 16 * 52, I1 = 16 * 16, I2 = 8 * 16 * 112;
    if (r < I0) { const int kt = r / 52, n0 = (r % 52) * 64; int nv = GLA_IN - n0; nv = nv < 0 ? 0 : (nv > 64 ? 64 : nv);
        cvt_tile(F, Src{F.ap->in[I_GWIN] + (size_t)j * 1024 * GLA_IN + n0, GLA_IN, nv}, kt * 64, W + WG_IN / 2 + (size_t)n0 * 1024, 1024, scr); return; } r -= I0;
    if (r < I1) { const int kt = r / 16, n0 = (r % 16) * 64;
        cvt_tile(F, Src{F.ap->in[I_GWOUT] + (size_t)j * 1024 * 1024 + n0, 1024, 64}, kt * 64, W + WG_OUT / 2 + (size_t)n0 * 1024, 1024, scr); return; } r -= I1;
    if (r < I2) { const int e = r / 1792, r2 = r % 1792, kt = r2 / 112, n0 = (r2 % 112) * 64; const int pn = n0 >> 8, p = n0 & 255, bj = p >> 7, rr = p & 127;
        const float* base = bj ? F.ap->in[I_MWU] : F.ap->in[I_MWG];
        cvt_tile_f8(F, Src{base + (size_t)(j * 8 + e) * 1024 * DFFE + 128 * pn + rr, DFFE, 64}, kt * 64, (unsigned char*)(F.ws + WS_WGLA) + WG_GU + ((size_t)e * 7168 + n0) * 1024, 1024, MOE_WGU_SCALE, scr); return; } r -= I2;
    { const int e = r / 896, r2 = r % 896, kt = r2 / 16, n0 = (r2 % 16) * 64;
        cvt_tile_f8(F, Src{F.ap->in[I_MWD] + (size_t)(j * 8 + e) * DFFE * 1024 + n0, 1024, 64}, kt * 64, (unsigned char*)(F.ws + WS_WGLA) + WG_DN + ((size_t)e * 1024 + n0) * DFFE, DFFE, MOE_WDN_SCALE, scr); }
}
DI void cvt_pull(Frame& F, int layer, int budget) {
    if (layer >= DEPTH) return;
    LAS unsigned* scr = (LAS unsigned*)(F.lds + F.wave * 16384);
    unsigned* q = (unsigned*)(F.ws + WS_CTL) + CW_CVTQ + 64 * layer;
    const int n = (layer & 1) ? CVT_GLA_ITEMS : CVT_RET_ITEMS, j = layer >> 1;
    for (int k = 0; budget < 0 || k < budget; k += 2) {
        int t = 0; if (F.lane == 0) t = (int)__hip_atomic_fetch_add(q, 2u, __ATOMIC_RELAXED, __HIP_MEMORY_SCOPE_AGENT);
        t = __builtin_amdgcn_readfirstlane(t);
        if (t >= n) break;
        if (layer & 1) { cvt_gla_item(F, j, t, scr); if (t + 1 < n) cvt_gla_item(F, j, t + 1, scr); }
        else           { cvt_ret_item(F, j, t, scr); if (t + 1 < n) cvt_ret_item(F, j, t + 1, scr); }
    }
}
DI void cvt_layer_static(Frame& F, int layer) {
    LAS unsigned* scr = (LAS unsigned*)(F.lds + F.wave * 16384); const int j = layer >> 1;
    if (layer & 1) { for (int it = F.gw; it < CVT_GLA_ITEMS; it += F.NGW) cvt_gla_item(F, j, it, scr); }
    else           { for (int it = F.gw; it < CVT_RET_ITEMS; it += F.NGW) cvt_ret_item(F, j, it, scr); }
}
DI void cvt_part(Frame& F, int layer, int first, int end, int idx, int per) {
    if (layer >= DEPTH) return;
    LAS unsigned* scr = (LAS unsigned*)(F.lds + F.wave * 16384); const int j = layer >> 1;
    for (int k = 0; k < per; ++k) { const int it = first + idx * per + k; if (it >= end) break;
        if (layer & 1) cvt_gla_item(F, j, it, scr); else cvt_ret_item(F, j, it, scr); }
}
DI void cvt_fill_after_gemm(Frame& F, int layer, int nwg, int budget) {
    const int c = (int)blockIdx.x, G = F.G; const int nu = (c < nwg) ? (nwg - 1 - c) / G + 1 : 0, maxr = (nwg + G - 1) / G;
    if (nu < maxr && F.wave < CVT_FILL_WAVES) cvt_pull(F, layer + 1, budget);
}

DI void ph_prologue(Frame& F) {
    LAS float* sc = (LAS float*)F.lds;
    LAS float* part = sc + 9 * 1024;
    float* mods = (float*)(F.ws + WS_MODS);
    for (int i = F.tid; i < 9 * 1024; i += 512) { const float c = (i < 8192) ? F.ap->in[I_C][i] : F.ap->in[I_CCTX][i - 8192]; sc[i] = silu(c); }
    __syncthreads();
    for (int item = blockIdx.x; item < 192; item += F.G) {
        const int li = item / 48, cg = item % 48, col = F.tid & 127, kq = F.tid >> 7;
        float acc[9];
#pragma unroll
        for (int s = 0; s < 9; ++s) acc[s] = 0.f;
        const float* w = F.ap->in[I_ADAW] + ((size_t)li * 1024 + kq * 256) * 6144 + cg * 128 + col;
        for (int k0 = 0; k0 < 256; k0 += 16) {
            float wq[16];
#pragma unroll
            for (int u = 0; u < 16; ++u) wq[u] = w[(size_t)(k0 + u) * 6144];
#pragma unroll
            for (int kk = 0; kk < 16; kk += 8) { const int k = k0 + kk; const float wv[8] = {wq[kk], wq[kk + 1], wq[kk + 2], wq[kk + 3], wq[kk + 4], wq[kk + 5], wq[kk + 6], wq[kk + 7]};
#pragma unroll
                for (int s = 0; s < 9; ++s) { const f32x4 c0 = *(const LAS f32x4*)(sc + s * 1024 + kq * 256 + k), c1 = *(const LAS f32x4*)(sc + s * 1024 + kq * 256 + k + 4);
                    acc[s] += (c0[0] * wv[0] + c0[1] * wv[1]) + (c0[2] * wv[2] + c0[3] * wv[3]) + (c1[0] * wv[4] + c1[1] * wv[5]) + (c1[2] * wv[6] + c1[3] * wv[7]); } }
        }
#pragma unroll
        for (int s = 0; s < 9; ++s) part[(kq * 9 + s) * 128 + col] = acc[s];
        __syncthreads();
        for (int o = F.tid; o < 9 * 128; o += 512) { const int s = o >> 7, cc = o & 127;
            const float v = (part[(0 * 9 + s) * 128 + cc] + part[(1 * 9 + s) * 128 + cc]) + (part[(2 * 9 + s) * 128 + cc] + part[(3 * 9 + s) * 128 + cc]) + F.ap->in[I_ADAB][li * 6144 + cg * 128 + cc];
            mods[(size_t)(li * 9 + s) * 6144 + cg * 128 + cc] = v; }
        __syncthreads();
    }
    float* ropec = (float*)(F.ws + WS_ROPE); float* ropes = ropec + 4096;
    for (int i = blockIdx.x * 512 + F.tid; i < 4096; i += F.G * 512) { const int pos = i >> 6, idx = i & 63;
        const float freq = exp2f(-(float)idx * (13.287712379549449f / 64.0f)); float sn, cs; sincosf((float)pos * freq, &sn, &cs); ropec[i] = cs; ropes[i] = sn; }
    __syncthreads();
}

template <int MODE, bool PF = false> DI void ph_norm(Frame& F,     int layer, int which, bool moe_in, int row_lo, const float* rd_ctx, const float* rd_lat, int nslab, const float* slab_gate, int cvt_layer = -1, int cvt_per_row = 0, int cvt_end = 1 << 30, int cvt_first = 0) {
    const float* mods = (const float*)(F.ws + WS_MODS);
    bf16* TOK = (bf16*)(F.ws + WS_TOK); bf16* HA = (bf16*)(F.ws + WS_HA); const bf16* YB = (const bf16*)(F.ws + WS_YB);
    const float* ng = (MODE == 2) ? F.ap->in[I_FING] : ((which ? F.ap->in[I_NFFN] : F.ap->in[I_NMIX]) + layer * 1024);
    const int lane = F.lane; const int j2 = layer >> 1;
    LAS int* lcnt = (LAS int*)F.lds; LAS int* lbase = lcnt + 8; LAS int* list = lcnt + 16;
    int nl = 0;
    LAS float* wl = (LAS float*)(F.lds + 65536);
    if (MODE == 1) { if (F.tid < 8) lcnt[F.tid] = 0;
        const float* wr = F.ap->in[I_MWR] + (size_t)j2 * 1024 * 8;
        f32x4 t4[4];
#pragma unroll
        for (int k = 0; k < 4; ++k) t4[k] = *(const f32x4*)(wr + (size_t)(F.tid + 512 * k) * 4);
#pragma unroll
        for (int k = 0; k < 4; ++k) { const int i = F.tid + 512 * k, r = i >> 1; *(LAS f32x4*)(wl + r * 8 + (r >> 2) * 4 + (i & 1) * 4) = t4[k]; }
        __syncthreads(); }
    f32x4 gv[4];
#pragma unroll
    for (int j = 0; j < 4; ++j) gv[j] = *(const f32x4*)(ng + 4 * lane + 256 * j);
    LAS unsigned* cvt_scr = (LAS unsigned*)(F.lds + 32768 + F.wave * 12288);
    int cvt_n = cvt_layer < 0 ? 0 : ((cvt_layer & 1) ? CVT_GLA_ITEMS : CVT_RET_ITEMS); cvt_n = cvt_n < cvt_end ? cvt_n : cvt_end; int cvt_it = cvt_first + F.gw;
    f32x4 xn[4]; u32x2 xr[4];
    f32x4 shn[4], scn[4];
#pragma unroll
    for (int j = 0; j < 4; ++j) { xn[j] = (f32x4){0.f, 0.f, 0.f, 0.f}; xr[j] = (u32x2){0u, 0u}; shn[j] = xn[j]; scn[j] = xn[j]; }
#define NORM_LOAD(rw) do { const float* rf_ = ((rw) < NCTX ? rd_ctx : rd_lat); \
        if (PF && MODE != 2) { const int s_ = (rw) < NCTX ? 8 : (((rw) - NCTX) >> 11); const float* mp_ = mods + (size_t)(layer * 9 + s_) * 6144 + (which ? 3072 : 0) + 4 * lane; \
            _Pragma("unroll") for (int j = 0; j < 4; ++j) { shn[j] = *(const f32x4*)(mp_ + 256 * j); scn[j] = *(const f32x4*)(mp_ + 1024 + 256 * j); } } \
        if (rf_) { const float* rr_ = rf_ + (size_t)(rw) * 1024 + 4 * lane; _Pragma("unroll") for (int j = 0; j < 4; ++j) xn[j] = *(const f32x4*)(rr_ + 256 * j); } \
        else { const bf16* rb_ = TOK + (size_t)(rw) * 1024 + 4 * lane; _Pragma("unroll") for (int j = 0; j < 4; ++j) xr[j] = *(const u32x2*)(rb_ + 256 * j); } } while (0)
    { const int row = row_lo + F.gw; if (row < NTOK) { NORM_LOAD(row);
        if (MODE == 2) { float* o = F.out + (size_t)(row - NCTX) * 1024 + 4 * lane;
#pragma unroll
            for (int j = 0; j < 4; ++j) *(f32x4*)(o + 256 * j) = (f32x4){0.f, 0.f, 0.f, 0.f}; }
        else if (MODE == 1) {
#pragma unroll
            for (int j = 0; j < 4; ++j) *(unsigned*)((unsigned char*)HA + (size_t)row * 1024 + 4 * lane + 256 * j) = 0u; }
        else {
#pragma unroll
            for (int j = 0; j < 4; ++j) *(u32x2*)(HA + (size_t)row * 1024 + 4 * lane + 256 * j) = (u32x2){0u, 0u}; } } }
    for (int row = row_lo + F.gw; row < NTOK; row += F.NGW) {
        const int s = row < NCTX ? 8 : ((row - NCTX) >> 11);
        bf16* tr = TOK + (size_t)row * 1024 + 4 * lane;
        f32x4 x[4];
        if ((row < NCTX ? rd_ctx : rd_lat) != nullptr) {
#pragma unroll
            for (int j = 0; j < 4; ++j) x[j] = xn[j];
        } else {
#pragma unroll
            for (int j = 0; j < 4; ++j) x[j] = (f32x4){bf_lo(xr[j].x), bf_hi(xr[j].x), bf_lo(xr[j].y), bf_hi(xr[j].y)};
        }
        f32x4 shv[4], scv[4];
        if (PF) {
#pragma unroll
            for (int j = 0; j < 4; ++j) { shv[j] = shn[j]; scv[j] = scn[j]; } }
        { const int rown = row + F.NGW; if (rown < NTOK) NORM_LOAD(rown); }
#undef NORM_LOAD
        if (MODE == 0) { for (int t = 0; t < cvt_per_row && cvt_it < cvt_n; ++t, cvt_it += F.NGW) { if (cvt_layer & 1) cvt_gla_item(F, cvt_layer >> 1, cvt_it, cvt_scr); else cvt_ret_item(F, cvt_layer >> 1, cvt_it, cvt_scr); } }

        if (!PF && MODE != 2) { const float* mp = mods + (size_t)(layer * 9 + s) * 6144 + (which ? 3072 : 0) + 4 * lane;
#pragma unroll
            for (int j = 0; j < 4; ++j) { shv[j] = *(const f32x4*)(mp + 256 * j); scv[j] = *(const f32x4*)(mp + 1024 + 256 * j); } }
        if (row < NCTX && nslab > 0) {
            const bf16* ps = (const bf16*)(F.ws + WS_PS) + (size_t)row * 1024 + 4 * lane;
            u32x2 pw[8][4]; f32x4 sg[4];
#pragma unroll
            for (int q = 0; q < 8; ++q)
#pragma unroll
                for (int j = 0; j < 4; ++j) { pw[q][j] = (u32x2){0u, 0u}; if (q < nslab) pw[q][j] = *(const u32x2*)(ps + (size_t)q * NCTX * 1024 + 256 * j); }
#pragma unroll
            for (int j = 0; j < 4; ++j) sg[j] = *(const f32x4*)(slab_gate + 4 * lane + 256 * j);
            u32x2 tw[4];
#pragma unroll
            for (int j = 0; j < 4; ++j) { f32x4 a = {0.f, 0.f, 0.f, 0.f};
#pragma unroll
                for (int q = 0; q < 8; ++q) a = a + (f32x4){bf_lo(pw[q][j].x), bf_hi(pw[q][j].x), bf_lo(pw[q][j].y), bf_hi(pw[q][j].y)};
                x[j] = x[j] + sg[j] * a; tw[j].x = pk2(x[j][0], x[j][1]); tw[j].y = pk2(x[j][2], x[j][3]); }
#pragma unroll
            for (int j = 0; j < 4; ++j) *(u32x2*)(tr + 256 * j) = tw[j];
        }
        if (moe_in) {
            const float* g2 = mods + (size_t)((layer - 1) * 9 + s) * 6144 + 5120 + 4 * lane; const bf16* y0 = YB + (size_t)row * (2048 * MOE_KSPLIT) + 4 * lane;
            u32x2 yw[2 * MOE_KSPLIT][4]; f32x4 g2v[4]; u32x2 tw[4];
#pragma unroll
            for (int q = 0; q < 2 * MOE_KSPLIT; ++q)
#pragma unroll
                for (int j = 0; j < 4; ++j) yw[q][j] = *(const u32x2*)(y0 + 1024 * q + 256 * j);
#pragma unroll
            for (int j = 0; j < 4; ++j) g2v[j] = *(const f32x4*)(g2 + 256 * j);
#pragma unroll
            for (int j = 0; j < 4; ++j) { f32x4 ya = {0.f, 0.f, 0.f, 0.f};
#pragma unroll
                for (int q = 0; q < 2 * MOE_KSPLIT; ++q) ya = ya + (f32x4){bf_lo(yw[q][j].x), bf_hi(yw[q][j].x), bf_lo(yw[q][j].y), bf_hi(yw[q][j].y)};
                x[j] = x[j] + g2v[j] * ya; tw[j].x = pk2(x[j][0], x[j][1]); tw[j].y = pk2(x[j][2], x[j][3]); }
            if (MODE != 2) {
#pragma unroll
                for (int j = 0; j < 4; ++j) *(u32x2*)(tr + 256 * j) = tw[j]; }
        }
        float ss = 0.f;
#pragma unroll
        for (int j = 0; j < 4; ++j) ss += (x[j][0] * x[j][0] + x[j][1] * x[j][1]) + (x[j][2] * x[j][2] + x[j][3] * x[j][3]);
        const float rstd = 1.0f / sqrtf(wave_sum(ss, lane) * (1.0f / 1024.0f) + EPS);
        if (MODE == 2) {
            float* o = F.out + (size_t)(row - NCTX) * 1024 + 4 * lane;
#pragma unroll
            for (int j = 0; j < 4; ++j) *(f32x4*)(o + 256 * j) = x[j] * rstd * gv[j];
        } else {
            f32x4 h[4];
#pragma unroll
            for (int j = 0; j < 4; ++j) { h[j] = x[j] * rstd * gv[j] * (scv[j] + 1.0f) + shv[j]; }
#pragma unroll
            for (int j = 0; j < 4; ++j) {
                if (MODE == 1) *(unsigned*)((unsigned char*)HA + (size_t)row * 1024 + 4 * lane + 256 * j) = pg8::pack4_fp8(h[j][0], h[j][1], h[j][2], h[j][3]);
                else { u32x2 w; w.x = pk2(h[j][0], h[j][1]); w.y = pk2(h[j][2], h[j][3]); *(u32x2*)(HA + (size_t)row * 1024 + 4 * lane + 256 * j) = w; } }
            if (MODE == 1) {
                float l[8];
#pragma unroll
                for (int e = 0; e < 8; ++e) l[e] = 0.f;
#pragma unroll
                for (int j = 0; j < 4; ++j)
#pragma unroll
                    for (int q = 0; q < 4; ++q) { const LAS float* wp = wl + (4 * lane + 256 * j + q) * 8 + (lane + 64 * j) * 4; const f32x4 w0 = *(const LAS f32x4*)wp, w1 = *(const LAS f32x4*)(wp + 4); const float hv = h[j][q];
                        l[0] += hv * w0[0]; l[1] += hv * w0[1]; l[2] += hv * w0[2]; l[3] += hv * w0[3]; l[4] += hv * w1[0]; l[5] += hv * w1[1]; l[6] += hv * w1[2]; l[7] += hv * w1[3]; }
#pragma unroll
                for (int e = 0; e < 8; ++e) l[e] = wave_sum(l[e], lane);
                int e0 = 0; float v0 = l[0];
#pragma unroll
                for (int e = 1; e < 8; ++e) if (l[e] > v0) { v0 = l[e]; e0 = e; }
                int e1 = -1; float v1 = -3.0e38f;
#pragma unroll
                for (int e = 0; e < 8; ++e) if (e != e0 && l[e] > v1) { v1 = l[e]; e1 = e; }
                const float w0 = 1.0f / (1.0f + __expf(v1 - v0));
                if (lane == 0) { const int p0 = __hip_atomic_fetch_add(lcnt + e0, 1, __ATOMIC_RELAXED, __HIP_MEMORY_SCOPE_WORKGROUP), p1 = __hip_atomic_fetch_add(lcnt + e1, 1, __ATOMIC_RELAXED, __HIP_MEMORY_SCOPE_WORKGROUP);
                    LAS int* q = list + (F.wave * 32 + nl) * 4; q[0] = row; q[1] = e0 | (e1 << 8); q[2] = p0 | (p1 << 16); q[3] = (int)__float_as_uint(w0); }
                ++nl;
            }
        }
    }
    if (MODE == 0) { for (; cvt_it < cvt_n; cvt_it += F.NGW) { if (cvt_layer & 1) cvt_gla_item(F, cvt_layer >> 1, cvt_it, cvt_scr); else cvt_ret_item(F, cvt_layer >> 1, cvt_it, cvt_scr); } }
    if (MODE == 1) {
        unsigned* gc = (unsigned*)(F.ws + WS_CTL) + CW_GCNT + 64 * j2;
        __syncthreads();
        if (F.tid < 8) lbase[F.tid] = (int)__hip_atomic_fetch_add(gc + F.tid, (unsigned)lcnt[F.tid], __ATOMIC_RELAXED, __HIP_MEMORY_SCOPE_AGENT);
        __syncthreads();
        if (lane < nl) { const LAS int* q = list + (F.wave * 32 + lane) * 4; const int row = q[0], ee = q[1], pp = q[2]; const float w0 = __uint_as_float((unsigned)q[3]);
            const int R0 = (ee & 255) * NTOK + lbase[ee & 255] + (pp & 0xffff), R1 = (ee >> 8) * NTOK + lbase[ee >> 8] + (pp >> 16);
            int* rinfo = (int*)(F.ws + WS_RINFO); float* rw = (float*)(F.ws + WS_RW);
            rinfo[R0] = row * 2; rw[R0] = w0; rinfo[R1] = row * 2 + 1; rw[R1] = 1.0f - w0; }
    }
}

DI void moe_counts(Frame& F, int j2, int (&cnt)[8]) {
    unsigned* gc = (unsigned*)(F.ws + WS_CTL) + CW_GCNT + 64 * j2;
#pragma unroll
    for (int e = 0; e < 8; ++e) cnt[e] = __builtin_amdgcn_readfirstlane((int)__hip_atomic_load(gc + e, __ATOMIC_RELAXED, __HIP_MEMORY_SCOPE_AGENT));
}
DI void ph_scatter(Frame& F, int j2, int row_lo) {
    LAS int* offs = (LAS int*)F.lds;
    int cnt[8]; moe_counts(F, j2, cnt);
    if (F.tid == 0) { int o = 0;
#pragma unroll
        for (int e = 0; e < 8; ++e) { offs[e] = o; offs[16 + e] = cnt[e]; o += (cnt[e] + 255) & ~255; }
        offs[8] = o; }
    __syncthreads();
    const int lane = F.lane;
    const bf16* HA = (const bf16*)(F.ws + WS_HA); unsigned char* AG8 = (unsigned char*)(F.ws + WS_AG);
    int* rinfo = (int*)(F.ws + WS_RINFO); float* rw = (float*)(F.ws + WS_RW);
    for (int row = row_lo + F.gw; row < NTOK; row += F.NGW) {
        const int ee = ((const int*)(F.ws + WS_TIE))[row], p0 = ((const int*)(F.ws + WS_TIP0))[row], p1 = ((const int*)(F.ws + WS_TIP1))[row];
        const float w0 = ((const float*)(F.ws + WS_TIW))[row];
        const u32x4* src = (const u32x4*)(HA + (size_t)row * 1024); const u32x4 a = src[2 * lane], b = src[2 * lane + 1];
        const int R0 = offs[ee & 255] + p0, R1 = offs[ee >> 8] + p1;
        u32x4 o8;
        o8.x = pg8::pack4_fp8(bf_lo(a.x), bf_hi(a.x), bf_lo(a.y), bf_hi(a.y)); o8.y = pg8::pack4_fp8(bf_lo(a.z), bf_hi(a.z), bf_lo(a.w), bf_hi(a.w));
        o8.z = pg8::pack4_fp8(bf_lo(b.x), bf_hi(b.x), bf_lo(b.y), bf_hi(b.y)); o8.w = pg8::pack4_fp8(bf_lo(b.z), bf_hi(b.z), bf_lo(b.w), bf_hi(b.w));
        ((u32x4*)(AG8 + (size_t)R0 * 1024))[lane] = o8; ((u32x4*)(AG8 + (size_t)R1 * 1024))[lane] = o8;
        if (lane == 0) { rinfo[R0] = row * 2; rw[R0] = w0; rinfo[R1] = row * 2 + 1; rw[R1] = 1.0f - w0; }
    }
    if (blockIdx.x < 8) { const int e = blockIdx.x; const int lo = offs[e] + offs[16 + e], hi = offs[e + 1];
        unsigned zz; asm volatile("v_mov_b32 %0, 0" : "=v"(zz));
        const u32x4 z = {zz, zz, zz, zz};
        for (int R = lo + F.wave; R < hi; R += NWAVES) { u32x4* d = (u32x4*)(AG8 + (size_t)R * 1024); d[lane] = z; if (lane == 0) rinfo[R] = -1; } }
}
DI void moe_order(Frame& F, int j2, int nN, int nsplit, int ntf, pg8::MoeOrder& S) {
    int cnt[8]; moe_counts(F, j2, cnt);
    int o = 0;
#pragma unroll
    for (int e = 0; e < 8; ++e) { S.poff[e] = o; S.cnt[e] = cnt[e]; o += (cnt[e] + 255) >> 8; }
    S.cap = NTOK;
    S.poff[8] = o; S.nM = o; S.nN = nN; S.nsplit = nsplit; S.ntf = ntf; S.nwg = o * nN * nsplit; S.G = F.G; S.c = (int)blockIdx.x;
}

template <bool GLA> DI void ph_finish(Frame& F, int j2, int row_lo) {
    const int lane = F.lane;
    const bf16* P = (const bf16*)(F.ws + WS_P); const bf16* OF = (const bf16*)(F.ws + WS_OF); const bf16* OB = (const bf16*)(F.ws + WS_OB); bf16* A2 = (bf16*)(F.ws + WS_A2);
    const int nit = (NTOK - row_lo) * 4; const int NGW = F.NGW;
    if (!GLA) {
        u32x4 an[2], bn[2], gn[2];
#pragma unroll
        for (int u = 0; u < 2; ++u) { an[u] = (u32x4){0u, 0u, 0u, 0u}; bn[u] = an[u]; gn[u] = an[u]; }
#define FIN_LOAD(u, it_) do { const int i_ = (it_); if (i_ < nit) { const int row = row_lo + (i_ >> 2), h = i_ & 3; const size_t ob = (size_t)row * 2048 + h * 512 + lane * 8; \
            an[u] = *(const u32x4*)(OF + ob); bn[u] = *(const u32x4*)(OB + ob); gn[u] = *(const u32x4*)(P + (size_t)row * RET_IN + 1024 + h * 512 + lane * 8); } } while (0)
        FIN_LOAD(0, F.gw); FIN_LOAD(1, F.gw + NGW);
        const int hw = F.gw & 3;
        const float* gw = F.ap->in[I_RGNW] + j2 * 2048 + hw * 512 + lane * 8; const float* gb = F.ap->in[I_RGNB] + j2 * 2048 + hw * 512 + lane * 8;
        const f32x4 w0 = *(const f32x4*)gw, w1 = *(const f32x4*)(gw + 4), b0 = *(const f32x4*)gb, b1 = *(const f32x4*)(gb + 4);
        for (int it = F.gw; it < nit; it += 2 * NGW) {
            u32x4 av[2], bv[2], gvv[2];
#pragma unroll
            for (int u = 0; u < 2; ++u) { av[u] = an[u]; bv[u] = bn[u]; gvv[u] = gn[u]; }
            FIN_LOAD(0, it + 2 * NGW); FIN_LOAD(1, it + 3 * NGW);
#pragma unroll
            for (int u = 0; u < 2; ++u) { const int itu = it + u * NGW;
                if (itu < nit) {
                    const int row = row_lo + (itu >> 2), h = itu & 3;
                    const size_t ob = (size_t)row * 2048 + h * 512 + lane * 8;
                    const u32x4 a = av[u], b = bv[u], g = gvv[u];
                    float o[8], gg[8];
#pragma unroll
                    for (int q = 0; q < 4; ++q) { o[2 * q] = bf_lo(a[q]) + bf_lo(b[q]); o[2 * q + 1] = bf_hi(a[q]) + bf_hi(b[q]); gg[2 * q] = bf_lo(g[q]); gg[2 * q + 1] = bf_hi(g[q]); }
                    float s = 0.f;
#pragma unroll
                    for (int q = 0; q < 8; ++q) s += o[q];
                    const float mean = wave_sum(s, lane) * (1.0f / 512.0f); float s2 = 0.f;
#pragma unroll
                    for (int q = 0; q < 8; ++q) { o[q] -= mean; s2 += o[q] * o[q]; }
                    const float rstd = __builtin_amdgcn_rsqf(wave_sum(s2, lane) * (1.0f / 512.0f) + EPS);
                    float y[8];
#pragma unroll
                    for (int q = 0; q < 8; ++q) { const float wv = q < 4 ? w0[q & 3] : w1[q & 3], bvv = q < 4 ? b0[q & 3] : b1[q & 3]; y[q] = (o[q] * rstd * wv + bvv) * silu(gg[q]); }
                    u32x4 w; w.x = pk2(y[0], y[1]); w.y = pk2(y[2], y[3]); w.z = pk2(y[4], y[5]); w.w = pk2(y[6], y[7]);
                    *(u32x4*)(A2 + ob) = w;
                }
            }
        }
#undef FIN_LOAD
    } else {
        u32x2 an[2], bn[2], gn[2];
#pragma unroll
        for (int u = 0; u < 2; ++u) { an[u] = (u32x2){0u, 0u}; bn[u] = an[u]; gn[u] = an[u]; }
#define FIN_LOAD(u, it_) do { const int i_ = (it_); if (i_ < nit) { const int row = row_lo + (i_ >> 2), h = i_ & 3; const size_t ob = (size_t)row * 1024 + h * 256 + lane * 4; \
            an[u] = *(const u32x2*)(OF + ob); bn[u] = *(const u32x2*)(OB + ob); gn[u] = *(const u32x2*)(P + (size_t)row * GLA_INP + 512 + h * 256 + lane * 4); } } while (0)
        FIN_LOAD(0, F.gw); FIN_LOAD(1, F.gw + NGW);
        const f32x4 w0 = *(const f32x4*)(F.ap->in[I_GNG] + j2 * 1024 + (F.gw & 3) * 256 + lane * 4);
        for (int it = F.gw; it < nit; it += 2 * NGW) {
            u32x2 av[2], bv[2], gvv[2];
#pragma unroll
            for (int u = 0; u < 2; ++u) { av[u] = an[u]; bv[u] = bn[u]; gvv[u] = gn[u]; }
            FIN_LOAD(0, it + 2 * NGW); FIN_LOAD(1, it + 3 * NGW);
#pragma unroll
            for (int u = 0; u < 2; ++u) { const int itu = it + u * NGW;
                if (itu < nit) {
                    const int row = row_lo + (itu >> 2), h = itu & 3;
                    const size_t ob = (size_t)row * 1024 + h * 256 + lane * 4;
                    const u32x2 a = av[u], b = bv[u], g = gvv[u];
                    float o[4], gg[4];
#pragma unroll
                    for (int q = 0; q < 2; ++q) { o[2 * q] = bf_lo(a[q]) + bf_lo(b[q]); o[2 * q + 1] = bf_hi(a[q]) + bf_hi(b[q]); gg[2 * q] = bf_lo(g[q]); gg[2 * q + 1] = bf_hi(g[q]); }
                    const float s2 = (o[0] * o[0] + o[1] * o[1]) + (o[2] * o[2] + o[3] * o[3]);
                    const float rstd = __builtin_amdgcn_rsqf(wave_sum(s2, lane) * (1.0f / 256.0f) + EPS);
                    float y[4];
#pragma unroll
                    for (int q = 0; q < 4; ++q) y[q] = o[q] * rstd * w0[q] * silu(gg[q]);
                    u32x2 w; w.x = pk2(y[0], y[1]); w.y = pk2(y[2], y[3]);
                    *(u32x2*)(A2 + ob) = w;
                }
            }
        }
#undef FIN_LOAD
    }
}

template <bool GLA> DI void ph_scan_naive(Frame& F, int j2) {
    constexpr int TB = 16, DK = GLA ? 128 : 256, VS = GLA ? 64 : 128, NDQ = 512 / VS, DPT = DK / NDQ;
    constexpr int PLD = GLA ? GLA_INP : RET_IN, QOFF = 0, KOFF = GLA ? 1536 : 3072, VOFF = GLA ? 2048 : 4096, DV = GLA ? 256 : 512, OLD = GLA ? 1024 : 2048;
    LAS float* qs = (LAS float*)F.lds;
    LAS float* ks = qs + TB * DK;
    LAS float* al = ks + TB * DK;
    LAS float* vs = al + TB * DK;
    LAS float* asv = vs + TB * VS;
    LAS float* part = asv + TB * 16;
    const bf16* P = (const bf16*)(F.ws + WS_P); const float* AF = (const float*)(F.ws + WS_AF);
    const int tid = F.tid, col = tid & (VS - 1), dq = tid / VS;
    for (int item = blockIdx.x; item < 256; item += F.G) {
        const int vsl = item & 3, dir = (item >> 2) & 1, h = (item >> 3) & 3, b = item >> 5;
        bf16* O = (bf16*)(F.ws + (dir ? WS_OB : WS_OF));
        float gamma = 1.f;
        if (!GLA) gamma = expf(-expf(F.ap->in[I_RDEC][j2 * 8 + dir * 4 + h]));
        const float* wup = F.ap->in[I_GWUP] + (size_t)((j2 * 2 + dir) * 16) * 512 + h * 128; const float* bg = F.ap->in[I_GBG] + (j2 * 2 + dir) * 512 + h * 128;
        float s[DPT];
#pragma unroll
        for (int d = 0; d < DPT; ++d) s[d] = 0.f;
        for (int seg = 0; seg < 2; ++seg) {
            const int L = seg ? SEQ : CTXL, rowbase = seg ? NCTX + b * SEQ : b * CTXL;
            for (int blk = 0; blk < L / TB; ++blk) {
                __syncthreads();
                {
                    constexpr int TPR = DK / 8;
                    const int which = tid / (TB * TPR);
                    if (GLA) { const int tt = (tid % (TB * TPR)) / TPR, d0 = (tid % TPR) * 8; const int pi = blk * TB + tt, t = dir ? L - 1 - pi : pi;
                        const u32x4 w = *(const u32x4*)(P + (size_t)(rowbase + t) * PLD + (which ? KOFF : QOFF) + h * DK + d0); LAS float* dst = (which ? ks : qs) + tt * DK + d0;
#pragma unroll
                        for (int q = 0; q < 4; ++q) { dst[2 * q] = bf_lo(w[q]); dst[2 * q + 1] = bf_hi(w[q]); }
                    } else { const int tt = tid / TPR, d0 = (tid % TPR) * 8; const int pi = blk * TB + tt, t = dir ? L - 1 - pi : pi;
                        const bf16* rp = P + (size_t)(rowbase + t) * PLD + h * DK + d0; const u32x4 wq = *(const u32x4*)(rp + QOFF), wk = *(const u32x4*)(rp + KOFF);
#pragma unroll
                        for (int q = 0; q < 4; ++q) { qs[tt * DK + d0 + 2 * q] = bf_lo(wq[q]); qs[tt * DK + d0 + 2 * q + 1] = bf_hi(wq[q]); ks[tt * DK + d0 + 2 * q] = bf_lo(wk[q]); ks[tt * DK + d0 + 2 * q + 1] = bf_hi(wk[q]); }
                    }
                    if (tid < TB * VS / 8) { const int tt = tid / (VS / 8), c0 = (tid % (VS / 8)) * 8; const int pi = blk * TB + tt, t = dir ? L - 1 - pi : pi;
                        const u32x4 w = *(const u32x4*)(P + (size_t)(rowbase + t) * PLD + VOFF + h * DV + vsl * VS + c0);
#pragma unroll
                        for (int q = 0; q < 4; ++q) { vs[tt * VS + c0 + 2 * q] = bf_lo(w[q]); vs[tt * VS + c0 + 2 * q + 1] = bf_hi(w[q]); } }
                    if (GLA && tid >= 256) { const int u = tid - 256, tt = u >> 4, r = u & 15; const int pi = blk * TB + tt, t = dir ? L - 1 - pi : pi; asv[tt * 16 + r] = AF[(size_t)(rowbase + t) * 32 + dir * 16 + r]; }
                }
                __syncthreads();
                if (GLA) {
                    const int tt = tid >> 5, d0 = (tid & 31) * 4;
                    f32x4 z = *(const f32x4*)(bg + d0);
#pragma unroll
                    for (int r = 0; r < 16; ++r) z = z + *(const f32x4*)(wup + (size_t)r * 512 + d0) * asv[tt * 16 + r];
#pragma unroll
                    for (int q = 0; q < 4; ++q) { const float zz = z[q]; const float ls = fminf(zz, 0.f) - log1pf(expf(-fabsf(zz))); al[tt * DK + d0 + q] = expf(ls * (1.0f / 16.0f)); }
                    __syncthreads();
                }
                for (int tt = 0; tt < TB; ++tt) {
                    const float vv = vs[tt * VS + col]; float po = 0.f;
#pragma unroll
                    for (int d4 = 0; d4 < DPT / 4; ++d4) {
                        const f32x4 kk = *(const LAS f32x4*)(ks + tt * DK + dq * DPT + 4 * d4), qq = *(const LAS f32x4*)(qs + tt * DK + dq * DPT + 4 * d4);
                        f32x4 aa = {gamma, gamma, gamma, gamma}; if (GLA) aa = *(const LAS f32x4*)(al + tt * DK + dq * DPT + 4 * d4);
#pragma unroll
                        for (int e = 0; e < 4; ++e) { s[4 * d4 + e] = aa[e] * s[4 * d4 + e] + kk[e] * vv; po += qq[e] * s[4 * d4 + e]; }
                    }
                    part[(tt * NDQ + dq) * VS + col] = po;
                }
                __syncthreads();
                {
                    constexpr int TPT = VS / 4;
                    if (tid < TB * TPT) { const int tt = tid / TPT, c4 = (tid % TPT) * 4; const int pi = blk * TB + tt, t = dir ? L - 1 - pi : pi;
                        f32x4 o = {0.f, 0.f, 0.f, 0.f};
#pragma unroll
                        for (int g = 0; g < NDQ; ++g) o = o + *(const LAS f32x4*)(part + (tt * NDQ + g) * VS + c4);
                        u32x2 w; w.x = pk2(o[0], o[1]); w.y = pk2(o[2], o[3]);
                        *(u32x2*)(O + (size_t)(rowbase + t) * OLD + h * DV + vsl * VS + c4) = w; }
                }
            }
        }
        __syncthreads();
    }
}

typedef short s16x4 __attribute__((ext_vector_type(4)));
typedef short s16x8 __attribute__((ext_vector_type(8)));
typedef __bf16 bf16x2_t __attribute__((ext_vector_type(2)));
DI unsigned pkc(float lo, float hi) { f32x2 v = {lo, hi}; return __builtin_bit_cast(unsigned, __builtin_convertvector(v, bf16x2_t)); }
DI s16x8 cat8(s16x4 lo, s16x4 hi) { return __builtin_shufflevector(lo, hi, 0, 1, 2, 3, 4, 5, 6, 7); }
DI s16x4 tr_rd(LAS unsigned char* p) { return __builtin_amdgcn_ds_read_tr16_b64_v4i16((LAS s16x4*)p); }
#define SCAN_BAR() do { asm volatile("s_waitcnt lgkmcnt(0)" ::: "memory"); __builtin_amdgcn_s_barrier(); asm volatile("" ::: "memory"); } while (0)
#define MFMA16(a, b, c) __builtin_amdgcn_mfma_f32_16x16x32_bf16((a), (b), (c), 0, 0, 0)

struct ScanTagT { static constexpr bool value = true; }; struct ScanTagF { static constexpr bool value = false; };
DI int scan_rowbase(int ci, int dir, int b) { const int nn = ci < 4 ? ci : ci - 4, ns = ci < 4 ? 4 : 32; const int cidx = dir ? ns - 1 - nn : nn; return (ci < 4 ? b * CTXL : NCTX + b * SEQ) + 64 * cidx; }
template <bool GLA> DI void ph_scan_mfma(Frame& F, int j2, int cvt_first = 0, int cvt_end = 0) {
    constexpr int DK = GLA ? 128 : 256, QLD = DK + 16, VLD = 136, PLDS = 80;
    constexpr int PLD = GLA ? GLA_INP : RET_IN, KOFF = GLA ? 1536 : 3072, VOFF = GLA ? 2048 : 4096, DV = GLA ? 256 : 512, OLD = GLA ? 1024 : 2048;
    constexpr int VS = GLA ? 64 : 128, NVW = VS / 16, NVP = VS / 64;
    constexpr int NITEMS = 256, NS = DK / 32, NDT = DK / 16, NQ = DK / 64;
    constexpr int KLD = DK + 16, KS_BYTES = 64 * KLD * 2 + 8 * 128;
#define SCAN_KROW(row) ((row) * (KLD * 2) + ((row) >> 3) * 128)
    constexpr int QS_OFF = 0, KS_OFF = 64 * QLD * 2, VS_OFF = KS_OFF + KS_BYTES, PM_OFF = VS_OFF + 64 * VLD * 2, QP_OFF = PM_OFF + 64 * PLDS * 2;
    static_assert(QP_OFF + 64 * QLD * 2 <= MISC_OFF, "scan LDS map");
    LAS unsigned char* L = F.lds;
    const int tid = F.tid, lane = F.lane, w = F.wave, g = lane >> 4, l15 = lane & 15, tq = l15 >> 2, tp = lane & 3;
    const bf16* P = (const bf16*)(F.ws + WS_P);
    for (int item0 = blockIdx.x; item0 < NITEMS; item0 += F.G) {
        int vsl, dir, h, b;
        {   const int x = item0 & 7, y = item0 >> 3; int grp;
            vsl = y & 3; grp = x + 8 * (y >> 2);
            dir = grp & 1; h = (grp >> 1) & 3; b = grp >> 3; }
        bf16* O = (bf16*)(F.ws + (dir ? WS_OB : WS_OF));
        float lgam = 0.f;
        if (!GLA) lgam = -expf(F.ap->in[I_RDEC][j2 * 8 + dir * 4 + h]);
        float qd[4], vsc[2];
#pragma unroll
        for (int nb = 0; nb < 4; ++nb) { const int t = 16 * nb + l15; qd[nb] = GLA ? 1.f : expf(lgam * (float)(dir ? 64 - t : t + 1)); }
#pragma unroll
        for (int i = 0; i < 2; ++i) { const int row = (tid + 512 * i) / (VS / 8); vsc[i] = GLA ? 1.f : expf(-lgam * (float)(dir ? 64 - row : row + 1)); }
        const float gC = GLA ? 1.f : expf(lgam * 64.f);
        const bf16* QG = GLA ? (const bf16*)(F.ws + WS_QT) + (size_t)dir * NTOK * 512 : P; const bf16* KG = GLA ? (const bf16*)(F.ws + WS_QT) + (size_t)(2 + dir) * NTOK * 512 : P + KOFF;
        constexpr int QGLD = GLA ? 512 : PLD;
        const float* EBG = (const float*)(F.ws + WS_EB);
        f32x4 S[NDT];
#pragma unroll
        for (int i = 0; i < NDT; ++i) S[i] = (f32x4){0.f, 0.f, 0.f, 0.f};
        u32x4 qreg[NQ], kreg[NQ], vreg[2];
#define SCAN_LOAD(ci) do { const int rb_ = scan_rowbase(ci, dir, b); \
        _Pragma("unroll") for (int i = 0; i < NQ; ++i) { const int p = tid + 512 * i, row = p / (DK / 8), c8 = p % (DK / 8); const unsigned o_ = (unsigned)(rb_ + row) * QGLD + h * DK + c8 * 8; qreg[i] = *(const u32x4*)(QG + o_); kreg[i] = *(const u32x4*)(KG + o_); }     \
        _Pragma("unroll") for (int i = 0; i < NVP; ++i) { const int p = tid + 512 * i, row = p / (VS / 8), c8 = p % (VS / 8); vreg[i] = *(const u32x4*)(P + ((unsigned)(rb_ + row) * PLD + VOFF + h * DV + vsl * VS + c8 * 8)); } } while (0)
        SCAN_LOAD(0);
        float cv[32]; unsigned char* cdst = nullptr; bool cact = false;
#define SCAN_CONV_ISSUE(cn_) do { const int hh = (cn_) * (4 * 256) + (int)blockIdx.x * 4 + (w - NVW), rq_ = cvt_first + (hh >> 1); \
                cact = GLA && (cn_) < 36 && rq_ < cvt_end; const int r = cact ? rq_ : 16 * 52 + 16 * 16;     \
                {   const int r2 = r - (16 * 52 + 16 * 16), e = r2 / 1792, r3 = r2 % 1792, kt = r3 / 112, n0 = (r3 % 112) * 64, pn = n0 >> 8, p = n0 & 255, bj = p >> 7, rr = p & 127, k0 = kt * 64 + (hh & 1) * 32; \
                    const float* base = bj ? F.ap->in[I_MWU] : F.ap->in[I_MWG]; \
                    const float* csrc = base + (size_t)(j2 * 8 + e) * 1024 * DFFE + 128 * pn + rr + (size_t)k0 * DFFE + lane; \
                    cdst = F.ws + WS_WGLA + WG_GU + ((size_t)e * 7168 + n0) * 1024 + k0; \
                    _Pragma("unroll") for (int i = 0; i < 32; ++i) cv[i] = __builtin_nontemporal_load(csrc + (size_t)i * DFFE); } } while (0)
        if (GLA && w >= NVW) SCAN_CONV_ISSUE(0);
        auto chunk_loop = [&](auto conv_tag) __attribute__((always_inline)) { constexpr bool CONV = decltype(conv_tag)::value;
        for (int ci = 0; ci < 36; ++ci) {
            const int rowbase = scan_rowbase(ci, dir, b);
            SCAN_BAR();
            f32x4 ebreg[GLA ? NDT : 1];
            if (CONV) {
            {
#pragma unroll
                for (int i = 0; i < NQ; ++i) { const int p = tid + 512 * i, row = p / (DK / 8), c8 = p % (DK / 8);
                    *(LAS u32x4*)(L + QS_OFF + (row * QLD + c8 * 8) * 2) = qreg[i]; *(LAS u32x4*)(L + KS_OFF + SCAN_KROW(row) + c8 * 16) = kreg[i];
                    { const int q4 = c8 & 3, pp = 32 * (c8 >> 2) + 16 * (q4 & 1) + 4 * (q4 >> 1); LAS unsigned char* qd2 = L + QP_OFF + (row * QLD + pp) * 2;
                      u32x2 lo2; lo2.x = qreg[i][0]; lo2.y = qreg[i][1]; u32x2 hi2; hi2.x = qreg[i][2]; hi2.y = qreg[i][3]; *(LAS u32x2*)qd2 = lo2; *(LAS u32x2*)(qd2 + 16) = hi2; } }
#pragma unroll
                for (int i = 0; i < NVP; ++i) { const int p = tid + 512 * i, row = p / (VS / 8), c8 = p % (VS / 8); u32x4 vo = vreg[i];
                    if (!GLA) {
#pragma unroll
                        for (int q = 0; q < 4; ++q) vo[q] = pkc(bf_lo(vreg[i][q]) * vsc[i], bf_hi(vreg[i][q]) * vsc[i]); }
                    *(LAS u32x4*)(L + VS_OFF + (row * VLD + c8 * 8) * 2) = vo; }
            }
                if (ci + 1 < 36) SCAN_LOAD(ci + 1);
            } else {
            {
#pragma unroll
                for (int i = 0; i < NQ; ++i) { const int p = tid + 512 * i, row = p / (DK / 8), c8 = p % (DK / 8);
                    *(LAS u32x4*)(L + QS_OFF + (row * QLD + c8 * 8) * 2) = qreg[i]; *(LAS u32x4*)(L + KS_OFF + SCAN_KROW(row) + c8 * 16) = kreg[i];
                    { const int q4 = c8 & 3, pp = 32 * (c8 >> 2) + 16 * (q4 & 1) + 4 * (q4 >> 1); LAS unsigned char* qd2 = L + QP_OFF + (row * QLD + pp) * 2;
                      u32x2 lo2; lo2.x = qreg[i][0]; lo2.y = qreg[i][1]; u32x2 hi2; hi2.x = qreg[i][2]; hi2.y = qreg[i][3]; *(LAS u32x2*)qd2 = lo2; *(LAS u32x2*)(qd2 + 16) = hi2; } }
#pragma unroll
                for (int i = 0; i < NVP; ++i) { const int p = tid + 512 * i, row = p / (VS / 8), c8 = p % (VS / 8); u32x4 vo = vreg[i];
                    if (!GLA) {
#pragma unroll
                        for (int q = 0; q < 4; ++q) vo[q] = pkc(bf_lo(vreg[i][q]) * vsc[i], bf_hi(vreg[i][q]) * vsc[i]); }
                    *(LAS u32x4*)(L + VS_OFF + (row * VLD + c8 * 8) * 2) = vo; }
            }
                if (ci + 1 < 36) SCAN_LOAD(ci + 1);
                if (GLA) { const float* eb = EBG + ((unsigned)((rowbase >> 6) * 2 + dir) * 512 + h * 128 + 4 * g);
#pragma unroll
                    for (int dkt = 0; dkt < NDT; ++dkt) ebreg[dkt] = *(const f32x4*)(eb + 16 * dkt); }
            }
            SCAN_BAR();
            {   const int ib = w >> 1; constexpr int NG = NS / 2;
                s16x8 fa[2][2], fb[2][2]; f32x4 acc2[2];
                acc2[0] = (f32x4){0.f, 0.f, 0.f, 0.f}; acc2[1] = (f32x4){0.f, 0.f, 0.f, 0.f};
#define SCAN_LDB(buf, u) do { const int jb_ = 2 * (w & 1) + (u) / NG; _Pragma("unroll") for (int k = 0; k < 2; ++k) { const int s_ = 2 * ((u) % NG) + k; \
                    fa[buf][k] = *(const LAS s16x8*)(L + KS_OFF + SCAN_KROW(16 * jb_ + l15) + (32 * s_ + 8 * g) * 2); fb[buf][k] = *(const LAS s16x8*)(L + QS_OFF + ((16 * ib + l15) * QLD + 32 * s_ + 8 * g) * 2); } } while (0)
                SCAN_LDB(0, 0);
#pragma unroll
                for (int u = 0; u < 2 * NG; ++u) {
                    if (u + 1 < 2 * NG) SCAN_LDB((u + 1) & 1, u + 1);
                    __builtin_amdgcn_sched_barrier(0);
#pragma unroll
                    for (int k = 0; k < 2; ++k) acc2[u / NG] = MFMA16(fa[u & 1][k], fb[u & 1][k], acc2[u / NG]);
                    __builtin_amdgcn_sched_barrier(0);
                }
#undef SCAN_LDB
                const int i = 16 * ib + l15;
#pragma unroll
                for (int tl = 0; tl < 2; ++tl) { const int jb = 2 * (w & 1) + tl; f32x4 acc = acc2[tl];
#pragma unroll
                    for (int r = 0; r < 4; ++r) { const int j = 16 * jb + 4 * g + r; const bool keep = dir ? (j >= i) : (j <= i); acc[r] = keep ? acc[r] : 0.f; }
                    u32x2 o; o.x = pkc(acc[0], acc[1]); o.y = pkc(acc[2], acc[3]);
                    *(LAS u32x2*)(L + PM_OFF + (i * PLDS + 16 * jb + 4 * g) * 2) = o; }
            }
            SCAN_BAR();
            if (!CONV && (NVW == NWAVES || w < NVW)) {   constexpr int NQG = NS, NKG = NDT / 2;
                s16x8 vf[2], fr[2][4];
#pragma unroll
                for (int ks = 0; ks < 2; ++ks) { LAS unsigned char* vp = L + VS_OFF + ((32 * ks + 8 * g + tq) * VLD + 16 * w + 4 * tp) * 2; vf[ks] = cat8(tr_rd(vp), tr_rd(vp + 4 * VLD * 2)); }
#define SCAN_LDP(buf, ks) do { _Pragma("unroll") for (int nb = 0; nb < 4; ++nb) fr[buf][nb] = *(const LAS s16x8*)(L + PM_OFF + ((16 * nb + l15) * PLDS + 32 * (ks) + 8 * g) * 2); } while (0)
                SCAN_LDP(0, 0);
#define SCAN_LDQ(buf, gq) do { _Pragma("unroll") for (int nb = 0; nb < 4; ++nb) fr[buf][nb] = *(const LAS s16x8*)(L + QP_OFF + ((16 * nb + l15) * QLD + 32 * (gq) + 8 * g) * 2); } while (0)
#define SCAN_LDK(buf, gk) do { _Pragma("unroll") for (int dd = 0; dd < 2; ++dd) _Pragma("unroll") for (int ks = 0; ks < 2; ++ks) { LAS unsigned char* kp = L + KS_OFF + SCAN_KROW(32 * ks + 8 * g + tq) + (16 * (2 * (gk) + dd) + 4 * tp) * 2; \
                    fr[buf][dd * 2 + ks] = cat8(tr_rd(kp), tr_rd(kp + 4 * KLD * 2)); } } while (0)
                f32x4 T[4];
#pragma unroll
                for (int nb = 0; nb < 4; ++nb) T[nb] = (f32x4){0.f, 0.f, 0.f, 0.f};
                SCAN_LDP(1, 1);
                __builtin_amdgcn_sched_barrier(0);
#pragma unroll
                for (int nb = 0; nb < 4; ++nb) T[nb] = MFMA16(vf[0], fr[0][nb], T[nb]);
                __builtin_amdgcn_sched_barrier(0);
                SCAN_LDQ(0, 0);
                __builtin_amdgcn_sched_barrier(0);
#pragma unroll
                for (int nb = 0; nb < 4; ++nb) T[nb] = MFMA16(vf[1], fr[1][nb], T[nb]);
                __builtin_amdgcn_sched_barrier(0);
#undef SCAN_LDP
#pragma unroll
                for (int gq = 0; gq < NQG; ++gq) {
                    if (gq + 1 < NQG) SCAN_LDQ((gq + 1) & 1, gq + 1); else SCAN_LDK((gq + 1) & 1, 0);
                    __builtin_amdgcn_sched_barrier(0);
                    {   const int s = gq;
                        u32x4 sp; sp.x = pkc(S[2 * s][0], S[2 * s][1]); sp.y = pkc(S[2 * s][2], S[2 * s][3]); sp.z = pkc(S[2 * s + 1][0], S[2 * s + 1][1]); sp.w = pkc(S[2 * s + 1][2], S[2 * s + 1][3]);
                        const s16x8 sf = __builtin_bit_cast(s16x8, sp);
#pragma unroll
                        for (int nb = 0; nb < 4; ++nb) T[nb] = MFMA16(sf, fr[gq & 1][nb], T[nb]); }
                    __builtin_amdgcn_sched_barrier(0);
                }
#pragma unroll
                for (int nb = 0; nb < 4; ++nb) { const f32x4 tv = T[nb] * qd[nb]; u32x2 o; o.x = pkc(tv[0], tv[1]); o.y = pkc(tv[2], tv[3]);
                    *(u32x2*)(O + ((unsigned)(rowbase + 16 * nb + l15) * OLD + h * DV + vsl * VS + 16 * w + 4 * g)) = o; }
#pragma unroll
                for (int gk = 0; gk < NKG; ++gk) {
                    if (gk + 1 < NKG) SCAN_LDK((NQG + gk + 1) & 1, gk + 1);
                    __builtin_amdgcn_sched_barrier(0);
#pragma unroll
                    for (int ks = 0; ks < 2; ++ks)
#pragma unroll
                        for (int dd = 0; dd < 2; ++dd) S[2 * gk + dd] = MFMA16(fr[(NQG + gk) & 1][dd * 2 + ks], vf[ks], S[2 * gk + dd]);
                    __builtin_amdgcn_sched_barrier(0);
                }
#undef SCAN_LDQ
#undef SCAN_LDK
                if (GLA) {
#pragma unroll
                    for (int dkt = 0; dkt < NDT; ++dkt) S[dkt] = S[dkt] * ebreg[dkt];
                } else {
#pragma unroll
                    for (int dkt = 0; dkt < NDT; ++dkt) S[dkt] = S[dkt] * gC;
                }
            } else if (CONV) { if (cact) {
                LAS unsigned* scr = (LAS unsigned*)(L + 90112 + (w - NVW) * 4096);
#pragma unroll
                for (int i = 0; i < 8; ++i) scr[lane * 9 + i] = pg8::pack4_fp8(cv[4 * i] * MOE_WGU_SCALE, cv[4 * i + 1] * MOE_WGU_SCALE, cv[4 * i + 2] * MOE_WGU_SCALE, cv[4 * i + 3] * MOE_WGU_SCALE);
                asm volatile("s_waitcnt lgkmcnt(0)" ::: "memory");
#pragma unroll
                for (int jj = 0; jj < 2; ++jj) { const int n = (lane >> 1) + 32 * jj, c = lane & 1; const LAS unsigned* q = scr + n * 9 + 4 * c;
                    u32x4 o; o.x = q[0]; o.y = q[1]; o.z = q[2]; o.w = q[3];
                    __builtin_nontemporal_store(o, (u32x4*)(cdst + (size_t)n * 1024 + 16 * c)); }
                asm volatile("s_waitcnt lgkmcnt(0)" ::: "memory"); }
                SCAN_CONV_ISSUE(ci + 1);
            }
        }
        };
        if (GLA && w >= NVW) chunk_loop(ScanTagT{}); else chunk_loop(ScanTagF{});
#undef SCAN_CONV_ISSUE
#undef SCAN_LOAD
#undef SCAN_KROW
        __syncthreads();
    }
}

DI void ph_gate_prep(Frame& F, int j2) {
    const int lane = F.lane;
    LAS float* as = (LAS float*)(F.lds + F.wave * 4096);
    const bf16* P = (const bf16*)(F.ws + WS_P); const float* AF = (const float*)(F.ws + WS_AF);
    bf16* QT = (bf16*)(F.ws + WS_QT); float* EBG = (float*)(F.ws + WS_EB);
    constexpr int NIT = (NTOK / 64) * 8;
    for (int k = 0; ; ++k) {
        const int it = k == 0 ? F.gw : F.NGW + (int)blockIdx.x + F.G * (F.wave + NWAVES * (k - 1));
        if (it >= NIT) break;
        const int h = it & 3, dir = (it >> 2) & 1, c = it >> 3, rowbase = c * 64, col = h * 128 + 2 * lane;
        LDS_WAIT();
        float at[16];
#pragma unroll
        for (int i = 0; i < 16; ++i) { const int idx = lane + 64 * i; at[i] = AF[(size_t)(rowbase + (idx >> 4)) * 32 + dir * 16 + (idx & 15)]; }
#pragma unroll
        for (int i = 0; i < 16; ++i) as[lane + 64 * i] = at[i];
        float w0[16], w1[16];
        const float* wp = F.ap->in[I_GWUP] + (size_t)((j2 * 2 + dir) * 16) * 512 + col;
#pragma unroll
        for (int r = 0; r < 16; ++r) { const f32x2 wv = *(const f32x2*)(wp + (size_t)r * 512); w0[r] = wv[0]; w1[r] = wv[1]; }
        const f32x2 bgv = *(const f32x2*)(F.ap->in[I_GBG] + (j2 * 2 + dir) * 512 + col);
        bf16* qo = QT + (size_t)dir * NTOK * 512; bf16* ko = QT + (size_t)(2 + dir) * NTOK * 512;
        LDS_WAIT();
        float b0 = 0.f, b1 = 0.f;
        for (int p8 = 0; p8 < 8; ++p8) {
            unsigned qv[8], kv[8];
#pragma unroll
            for (int u = 0; u < 8; ++u) { const int pi = 8 * p8 + u, tok = dir ? 63 - pi : pi; const bf16* rp = P + (size_t)(rowbase + tok) * GLA_INP + col; qv[u] = *(const unsigned*)rp; kv[u] = *(const unsigned*)(rp + 1536); }
#pragma unroll
            for (int u = 0; u < 8; ++u) { const int pi = 8 * p8 + u, tok = dir ? 63 - pi : pi;
                float z0 = bgv[0], z1 = bgv[1];
#pragma unroll
                for (int r4 = 0; r4 < 4; ++r4) { const f32x4 av = *(const LAS f32x4*)(as + tok * 16 + 4 * r4);
#pragma unroll
                    for (int q = 0; q < 4; ++q) { z0 += av[q] * w0[4 * r4 + q]; z1 += av[q] * w1[4 * r4 + q]; } }
                b0 += (fminf(z0, 0.f) - __logf(1.0f + __expf(-fabsf(z0)))) * (1.0f / 16.0f);
                b1 += (fminf(z1, 0.f) - __logf(1.0f + __expf(-fabsf(z1)))) * (1.0f / 16.0f);
                const float e0 = __expf(b0), e1 = __expf(b1), i0 = __builtin_amdgcn_rcpf(e0), i1 = __builtin_amdgcn_rcpf(e1);
                const size_t o = (size_t)(rowbase + tok) * 512 + col;
                *(unsigned*)(qo + o) = pkc(bf_lo(qv[u]) * e0, bf_hi(qv[u]) * e1);
                *(unsigned*)(ko + o) = pkc(bf_lo(kv[u]) * i0, bf_hi(kv[u]) * i1);
            }
        }
        f32x2 ev; ev[0] = __expf(b0); ev[1] = __expf(b1);
        *(f32x2*)(EBG + (size_t)(c * 2 + dir) * 512 + col) = ev;
    }
}

#ifndef SCAN_RET_MFMA
#define SCAN_RET_MFMA 1
#endif
#ifndef SCAN_GLA_MFMA
#define SCAN_GLA_MFMA 1
#endif
#ifndef PROBE_MASK
#define PROBE_MASK 0
#endif
constexpr int NPHASES = 1 + 8 + 9 + 8 + 9 + 1 + ((PROBE_MASK & 128) ? 2 : 0) + ((PROBE_MASK & 256) ? 2 : 0);
#define REP(bit) for (int rep_ = 0; rep_ < ((PROBE_MASK & (bit)) ? 2 : 1); ++rep_)
#ifndef CVT_BUDGET_K1024
#define CVT_BUDGET_K1024 4
#define CVT_BUDGET_K2048 8
#define CVT_BUDGET_K2816 12
#define CVT_BUDGET_K3584 16
#define CVT_BUDGET_GLASCAN 8
#endif
#ifndef GU_TAIL
#define GU_TAIL 2
#define IN_TAIL 2
#define DN_TAIL 4
#endif
#ifndef GI_TAIL
#define GI_TAIL 5
#endif
constexpr int TAIL_GI = 88 * NWAVES * GI_TAIL, CVT_GLA_PRE = CVT_GLA_ITEMS - TAIL_GI;
constexpr int TAIL_GU = 208 * NWAVES * GU_TAIL, TAIL_IN = 64 * NWAVES * IN_TAIL;
constexpr int SCAN_CVT_FIRST = 16 * 52 + 16 * 16;
static_assert(CVT_GLA_PRE - TAIL_GU - TAIL_IN - SCAN_CVT_FIRST <= 36 * 1024 / 2 && CVT_GLA_PRE - TAIL_GU - TAIL_IN <= 16 * 52 + 16 * 16 + 8 * 16 * 112, "in-scan conversion: capacity, and gate/up tiles only");
#ifndef CTX_SPLIT
#define CTX_SPLIT 1
#endif
#ifndef N_LAUNCH_MODE
#define N_LAUNCH_MODE 1
#endif

__global__ void __launch_bounds__(NWAVES * 64, 2) fwd(Args args) {
    extern __shared__ __attribute__((aligned(16))) unsigned char lds_raw[];
    Frame F;
    F.lds = (LAS unsigned char*)lds_raw;
    F.tid = threadIdx.x; F.lane = F.tid & 63; F.wave = __builtin_amdgcn_readfirstlane(F.tid >> 6);
    F.G = gridDim.x; F.gw = blockIdx.x * NWAVES + F.wave; F.NGW = F.G * NWAVES;
    F.ws = args.ws; F.out = args.out;
    F.ap = (const __attribute__((address_space(4))) Args*)__builtin_amdgcn_kernarg_segment_ptr();
    volatile LAS unsigned* MISC = (volatile LAS unsigned*)(F.lds + MISC_OFF);
    if (F.tid < 32) MISC[F.tid] = 0u;
    __syncthreads();
    const int lo = args.lo, hi = args.hi;
    unsigned* barw = (unsigned*)(F.ws + WS_CTL) + CW_BAR;
    XcdBarrier bar; bar.bar = barw; bar.x = 0; bar.st = MISC + 8;
    if (hi - lo > 1) bar = xcd_barrier_post(barw, MISC + 8);
    int ph = 0;
#define PHASE_BEGIN if (ph >= lo && ph < hi) { { int ln_; asm volatile("v_mbcnt_lo_u32_b32 %0, -1, 0\n\tv_mbcnt_hi_u32_b32 %0, -1, %0" : "=v"(ln_)); F.lane = ln_; F.tid = F.wave * 64 + ln_; } asm volatile("" : "+s"(F.ap)); asm volatile("" : "+s"(F.gw));
#ifndef SITE_MASK
#define SITE_MASK 0xFFFFFFFFu
#endif
#define SITE(k) if (SITE_MASK & (1u << (k)))
#define PHASE_END   if (ph + 1 < hi) { xcd_barrier(bar); if (PROBE_MASK & 64) xcd_barrier(bar); } } ++ph;
    const float* mods = (const float*)(F.ws + WS_MODS);
    bf16* HA = (bf16*)(F.ws + WS_HA); bf16* TOK = (bf16*)(F.ws + WS_TOK); const float* const NOF32 = nullptr;

    PHASE_BEGIN SITE(0) { REP(4) { __syncthreads(); ph_prologue(F); } REP(2) cvt_layer_static(F, 0); } PHASE_END

    for (int layer = 0; layer < DEPTH; ++layer) {
        const int j2 = layer >> 1; const int rlo = (layer == DEPTH - 1) ? NCTX : 0;
        if ((layer & 1) == 0) {
            const bf16* W = (const bf16*)(F.ws + WS_WRET);
            PHASE_BEGIN SITE(1) { const int lpos = __builtin_amdgcn_readfirstlane(layer > 0 ? 1 : 0);
                                  int cvt_done = 0;
                                  if (lpos != 0 && F.G == 256) { int cnt_[8]; moe_counts(F, (layer - 1) >> 1, cnt_); int nm_ = 0;
#pragma unroll
                                      for (int e = 0; e < 8; ++e) nm_ += (cnt_[e] + 255) >> 8;
                                      const int busy_ = nm_ * 4 * MOE_KSPLIT - 2 * 256; if (busy_ >= 0 && busy_ <= 96) cvt_done = CVT_RET_ITEMS; }
                                  REP(4) ph_norm<0>(F, layer, 0, lpos != 0 && rep_ == 0, 0, layer == 0 ? F.ap->in[I_CTX] : NOF32, layer == 0 ? F.ap->in[I_X] - (size_t)NCTX * D : NOF32, 0, mods, (lpos != 0 && rep_ == 0) ? layer : -1, 1, 1 << 30, cvt_done); } PHASE_END
            PHASE_BEGIN SITE(2) { REP(8) { pg8::Gemm g{HA, W + WR_IN / 2, NTOK, RET_IN, D}; pg8::StaticOrder S; S.init(NTOK, RET_IN, F.G, (int)blockIdx.x, D);
                          pg8::EpiRetIn E{(bf16*)(F.ws + WS_P), (const float*)(F.ws + WS_ROPE), (const float*)(F.ws + WS_ROPE) + 4096};
                          pg8::gemm_phase<pg8::EpiRetIn, pg8::StaticOrder, true, true>(F.lds, g, S, E, F.tid);
                          if (F.G == 256 && rep_ == 0 && (int)blockIdx.x >= 192) cvt_part(F, layer + 1, CVT_GLA_PRE - TAIL_GU - TAIL_IN, CVT_GLA_PRE - TAIL_GU, ((int)blockIdx.x - 192) * NWAVES + F.wave, IN_TAIL); } } PHASE_END
            PHASE_BEGIN SITE(3) { REP(1 | 16) if (SCAN_RET_MFMA) ph_scan_mfma<false>(F, j2); else ph_scan_naive<false>(F, j2); } PHASE_END
            PHASE_BEGIN SITE(4) { REP(4) ph_finish<false>(F, j2, 0); } PHASE_END
            PHASE_BEGIN SITE(5) { { pg8::Gemm g{(const bf16*)(F.ws + WS_A2), W + WR_OUT / 2, NTOK, D, 2048}; pg8::ResidOrder S; S.init(NTOK, D, F.G, (int)blockIdx.x, 2048, CTX_SPLIT ? NCTX / 256 : 0, 8);
                          pg8::EpiResid E{TOK, layer == 0 ? F.ap->in[I_X] - (size_t)NCTX * D : NOF32, layer == 0 ? F.ap->in[I_CTX] : NOF32, mods + (size_t)layer * 9 * 6144 + 2048, 0, (bf16*)(F.ws + WS_PS), CTX_SPLIT ? NCTX / 256 : 0};
                          pg8::gemm_phase<pg8::EpiResid, pg8::ResidOrder, true, true>(F.lds, g, S, E, F.tid); } } PHASE_END
            PHASE_BEGIN SITE(6) { REP(4) ph_norm<0, true>(F, layer, 1, false, 0, (CTX_SPLIT && layer == 0) ? F.ap->in[I_CTX] : NOF32, NOF32, (CTX_SPLIT && rep_ == 0) ? 8 : 0, mods + (size_t)(layer * 9 + 8) * 6144 + 2048); } PHASE_END
            PHASE_BEGIN SITE(7) { REP(8) { pg8::Gemm g{HA, W + WR_GU / 2, NTOK, 2 * DFF, D}; pg8::StaticOrder S; S.init(NTOK, 2 * DFF, F.G, (int)blockIdx.x, D);
                          pg8::EpiSwigluF8 E{(unsigned char*)(F.ws + WS_HID), DFF};
                          pg8::gemm_phase<pg8::EpiSwigluF8, pg8::StaticOrder, true, true>(F.lds, g, S, E, F.tid);
                          if (F.G == 256 && rep_ == 0 && (int)blockIdx.x >= 48) cvt_part(F, layer + 1, CVT_GLA_PRE - TAIL_GU, CVT_GLA_PRE, ((int)blockIdx.x - 48) * NWAVES + F.wave, GU_TAIL); } } PHASE_END
            if (PROBE_MASK & 128) { PHASE_BEGIN SITE(20) { pg8::Gemm g{HA, W + WR_GU / 2, NTOK, 2 * DFF, D}; pg8::StaticOrder S; S.init(NTOK, 2 * DFF, F.G, (int)blockIdx.x, D);
                          pg8::EpiNull E{}; pg8::gemm_phase<pg8::EpiNull, pg8::StaticOrder, true, true>(F.lds, g, S, E, F.tid); } PHASE_END }
            if (PROBE_MASK & 256) { PHASE_BEGIN SITE(21) { pg8::Gemm g{HA, W + WR_GU / 2, NTOK, 2 * DFF, D}; pg8::StaticOrder S; S.init(NTOK, 2 * DFF, F.G, (int)blockIdx.x, D);
                          pg8::EpiSwiglu E{(bf16*)(F.ws + WS_OF), DFF}; pg8::gemm_phase<pg8::EpiSwiglu, pg8::StaticOrder, true, true>(F.lds, g, S, E, F.tid); } PHASE_END }
            PHASE_BEGIN SITE(8) { { pg8::Gemm g{(const bf16*)(F.ws + WS_HID), (const bf16*)(F.ws + WS_WRET + WR_DN), NTOK, D, DFF / 2, E8M0_2M7, E8M0_2M1}; pg8::ResidOrder S; S.init(NTOK, D, F.G, (int)blockIdx.x, DFF / 2, CTX_SPLIT ? NCTX / 256 : 0, 4);
                          pg8::EpiResid E{TOK, NOF32, NOF32, mods + (size_t)layer * 9 * 6144 + 5120, 0, (bf16*)(F.ws + WS_PS), CTX_SPLIT ? NCTX / 256 : 0};
                          pg8::gemm_phase<pg8::EpiResid, pg8::ResidOrder, true, true, true>(F.lds, g, S, E, F.tid); } } PHASE_END
        } else {
            const bf16* W = (const bf16*)(F.ws + WS_WGLA);
            PHASE_BEGIN SITE(9) { REP(4) ph_norm<0>(F, layer, 0, false, 0, NOF32, NOF32, (CTX_SPLIT && rep_ == 0) ? 4 : 0, mods + (size_t)((layer - 1) * 9 + 8) * 6144 + 5120, rep_ == 0 ? layer : -1, 2, F.G == 256 ? SCAN_CVT_FIRST : (1 << 30)); } PHASE_END
            PHASE_BEGIN SITE(10) { REP(8) { pg8::Gemm g{HA, W + WG_IN / 2, NTOK, GLA_INP, D}; pg8::StaticOrder S; S.init(NTOK, GLA_INP, F.G, (int)blockIdx.x, D);
                          pg8::EpiGlaIn E{(bf16*)(F.ws + WS_P), (float*)(F.ws + WS_AF)};
                          pg8::gemm_phase<pg8::EpiGlaIn, pg8::StaticOrder, true, true>(F.lds, g, S, E, F.tid);
                          if (F.G == 256 && rep_ == 0 && (int)blockIdx.x >= 168) cvt_part(F, layer, CVT_GLA_PRE, CVT_GLA_ITEMS, ((int)blockIdx.x - 168) * NWAVES + F.wave, GI_TAIL); } } PHASE_END
            PHASE_BEGIN SITE(19) { REP(32) ph_gate_prep(F, j2); } PHASE_END
            PHASE_BEGIN SITE(11) { REP(1 | 32) if (SCAN_GLA_MFMA) ph_scan_mfma<true>(F, j2, (F.G == 256 && rep_ == 0) ? SCAN_CVT_FIRST : 0, (F.G == 256 && rep_ == 0) ? CVT_GLA_PRE - TAIL_GU - TAIL_IN : 0); else ph_scan_naive<true>(F, j2); } PHASE_END
            PHASE_BEGIN SITE(12) { REP(4) ph_finish<true>(F, j2, rlo); } PHASE_END
            PHASE_BEGIN SITE(13) { { pg8::Gemm g{(const bf16*)(F.ws + WS_A2) + (size_t)rlo * 1024, W + WG_OUT / 2, NTOK - rlo, D, D}; pg8::ResidOrder S; S.init(NTOK - rlo, D, F.G, (int)blockIdx.x, D, CTX_SPLIT ? (NCTX - rlo) / 256 : 0, 4);
                          pg8::EpiResid E{TOK, NOF32, NOF32, mods + (size_t)layer * 9 * 6144 + 2048, rlo, (bf16*)(F.ws + WS_PS), CTX_SPLIT ? (NCTX - rlo) / 256 : 0};
                          pg8::gemm_phase<pg8::EpiResid, pg8::ResidOrder, true, true>(F.lds, g, S, E, F.tid); } } PHASE_END
            PHASE_BEGIN SITE(14) { ph_norm<1, true>(F, layer, 1, false, rlo, NOF32, NOF32, (CTX_SPLIT && rlo == 0) ? 4 : 0, mods + (size_t)(layer * 9 + 8) * 6144 + 2048); if (PROBE_MASK & 4) ph_norm<0>(F, layer, 1, false, rlo, NOF32, NOF32, 0, mods); } PHASE_END
            PHASE_BEGIN SITE(16) { REP(8) { pg8::MoeOrder S; moe_order(F, j2, 28, 1, D / 128, S); pg8::Gemm g{(const bf16*)(F.ws + WS_HA), (const bf16*)(F.ws + WS_WGLA + WG_GU), S.nM * 256, 7168, D / 2, E8M0_2M6, E8M0_1, (const int*)(F.ws + WS_RINFO)};
                          pg8::EpiSwigluF8 E{(unsigned char*)(F.ws + WS_HIDG), DFFE};
                          pg8::gemm_phase<pg8::EpiSwigluF8, pg8::MoeOrder, true, true, true, true>(F.lds, g, S, E, F.tid); } } PHASE_END
            PHASE_BEGIN SITE(17) { REP(8) { pg8::MoeOrder S; moe_order(F, j2, 4, MOE_KSPLIT, DFFE / 128, S); pg8::Gemm g{(const bf16*)(F.ws + WS_HIDG), (const bf16*)(F.ws + WS_WGLA + WG_DN), S.nM * 256, D, DFFE / 2, E8M0_2M7, E8M0_2M1};
                          pg8::EpiMoeDown E{(bf16*)(F.ws + WS_YB), (const int*)(F.ws + WS_RINFO), (const float*)(F.ws + WS_RW)};
                          pg8::gemm_phase<pg8::EpiMoeDown, pg8::MoeOrder, true, true, true>(F.lds, g, S, E, F.tid);
                          { const int busy = S.nwg - 2 * 256; if (F.G == 256 && rep_ == 0 && busy >= 0 && busy <= 96 && (int)blockIdx.x >= busy) cvt_part(F, layer + 1, 0, CVT_RET_ITEMS, ((int)blockIdx.x - busy) * NWAVES + F.wave, DN_TAIL); } } } PHASE_END
        }
    }
    PHASE_BEGIN SITE(18) { REP(4) ph_norm<2>(F, DEPTH, 0, true, NCTX, NOF32, NOF32, 0, mods); } PHASE_END
#undef PHASE_BEGIN
#undef PHASE_END
}

extern "C" void kernel_launch(void* const* d_in, const int* in_sizes, int n_in, void* d_out, int out_size, void* d_ws, size_t ws_size, hipStream_t stream) {
    static int grid = 0;
    if (grid == 0) {
        if (n_in != 26 || in_sizes[0] != NLAT * D || out_size != NLAT * D || ws_size < WS_END) {
            fprintf(stderr, "kernel_launch: unexpected shapes: n_in %d in0 %d out %d ws %zu (need %zu)\n", n_in, n_in > 0 ? in_sizes[0] : -1, out_size, ws_size, (size_t)WS_END); grid = -1; return; }
        int dev = 0, cus = 0, per_cu = 0;
        if (hipGetDevice(&dev) != hipSuccess || hipDeviceGetAttribute(&cus, hipDeviceAttributeMultiprocessorCount, dev) != hipSuccess) { grid = -1; return; }
        if (hipFuncSetAttribute((const void*)fwd, hipFuncAttributeMaxDynamicSharedMemorySize, LDS_BYTES) != hipSuccess) { fprintf(stderr, "kernel_launch: hipFuncSetAttribute failed\n"); grid = -1; return; }
        if (hipOccupancyMaxActiveBlocksPerMultiprocessor(&per_cu, (const void*)fwd, NWAVES * 64, LDS_BYTES) != hipSuccess || per_cu < 1)
            fprintf(stderr, "kernel_launch: note: occupancy query reports %d workgroups per CU\n", per_cu);
        (void)hipGetLastError();
        grid = cus;
    }
    if (grid < 0) return;
    if (hipMemsetAsync((char*)d_ws + WS_CTL, 0, CTL_ZERO_BYTES, stream) != hipSuccess) { fprintf(stderr, "kernel_launch: memset failed\n"); return; }
    Args a{};
    for (int i = 0; i < 26; ++i) a.in[i] = (const float*)d_in[i];
    a.out = (float*)d_out; a.ws = (unsigned char*)d_ws;
#if N_LAUNCH_MODE == 1
    a.lo = 0; a.hi = NPHASES;
    hipLaunchKernelGGL(fwd, dim3(grid), dim3(NWAVES * 64), LDS_BYTES, stream, a);
#else
    for (int p = 0; p < NPHASES; ++p) { a.lo = p; a.hi = p + 1; hipLaunchKernelGGL(fwd, dim3(grid), dim3(NWAVES * 64), LDS_BYTES, stream, a); }
#endif
}
```

```cpp
#include <hip/hip_runtime.h>
#include <cstdio>
#include <cstdint>
namespace pg8 {
#define PG8_LAS __attribute__((address_space(3)))
typedef unsigned short bf16_t;
typedef short bf16x8 __attribute__((ext_vector_type(8)));
typedef float f32x4 __attribute__((ext_vector_type(4)));
typedef unsigned u32x4 __attribute__((ext_vector_type(4)));
typedef int i32x4_t __attribute__((ext_vector_type(4)));
typedef int i32x8_t __attribute__((ext_vector_type(8)));
constexpr int BM = 256, BK = 64, HALF = 128, HTB = HALF * BK * 2  , STAGE_BYTES = 8 * HTB, NXCD = 8, WGM = 4;

__host__ __device__ __forceinline__ int lds_byte(int r, int c) { const int st = (r >> 4) * 2 + (c >> 5), rr = r & 15, cc = c & 31, ob = rr * 64 + cc * 2; return st * 1024 + (ob ^ (((ob >> 9) & 1) << 5)); }
__host__ __device__ __forceinline__ void stage_rc(int b, int& R, int& C) { const int st = b / 1024, sb = b % 1024, swz = sb ^ (((sb >> 9) & 1) << 5); R = (st >> 1) * 16 + swz / 64; C = (st & 1) * 32 + (swz % 64) / 2; }
__host__ __device__ __forceinline__ int perm32(int rho) { const int n = rho >> 4, i = rho & 15; return 8 * (i >> 2) + 4 * n + (i & 3); }

struct Unit { int pm, pn, pb, ks, koff, nt, fix, lim; };
struct Gemm { const bf16_t* A; const bf16_t* Bt; int M, N, K; unsigned sw, sx; const int* gidx; };

struct StaticOrder {
    int nM, nN, nwg, G, c, ntf;
    __host__ __device__ void init(int M, int N, int G_, int c_, int K_) { nM = M / BM; nN = N / BM; nwg = nM * nN; G = G_; c = c_; ntf = K_ / BK; }
    __host__ __device__ bool next(int i, Unit& u) const {
        const long L = (long)i * G + c; if (L >= nwg) return false;
        int wgid = (int)L; { const int q = nwg / NXCD, r = nwg % NXCD, xcd = wgid % NXCD, off = wgid / NXCD; wgid = (xcd < r ? xcd * (q + 1) : r * (q + 1) + (xcd - r) * q) + off; }
        const int nig = WGM * nN, gid = wgid / nig, fm = gid * WGM, gsz = (nM - fm) < WGM ? (nM - fm) : WGM;
        u.pm = fm + ((wgid % nig) % gsz); u.pn = (wgid % nig) / gsz; u.pb = u.pn; u.ks = 0; u.koff = 0; u.nt = ntf; u.fix = 0; u.lim = 0; return true;
    }
    __device__ __forceinline__ void a_ready(const Unit&) const {}
    __device__ __forceinline__ void done(const Unit&) const {}
};

__device__ __forceinline__ unsigned cvt_pk_bf16(float lo, float hi) { unsigned r; asm volatile("v_cvt_pk_bf16_f32 %0, %1, %2" : "=v"(r) : "v"(lo), "v"(hi)); return r; }
__device__ __forceinline__ u32x4 pack8(const f32x4 a, const f32x4 b) { u32x4 w; w.x = cvt_pk_bf16(a[0], a[1]); w.y = cvt_pk_bf16(a[2], a[3]); w.z = cvt_pk_bf16(b[0], b[1]); w.w = cvt_pk_bf16(b[2], b[3]); return w; }
__device__ __forceinline__ float silu_f(float x) { return x * __builtin_amdgcn_rcpf(1.0f + __builtin_amdgcn_exp2f(x * -1.4426950408889634f)); }

struct EpiRetIn {
    static constexpr bool PERM = true, AFTER_DRAIN = false;
    bf16_t* P; const float* ropec; const float* ropes;
    __device__ __forceinline__ void operator()(const f32x4 (&acc)[2][2][4][2], const Unit& u, int wr, int wc, int fr, int fq) const {
        const int pn = u.pn; const bool isq = pn < 4, isk = (pn >= 12 && pn < 16);
        const int cb = wc * 32 + 8 * fq;
        const float ksc = isk ? 0.0625f : 1.0f;
        const bool rot = (isq || isk) && (u.pm * BM >= 2048);
#pragma unroll
        for (int ai = 0; ai < 2; ++ai) {
            f32x4 cc[4][2], ss[4][2];
            if (rot) {
#pragma unroll
                for (int m = 0; m < 4; ++m) { const int row = u.pm * BM + ai * HALF + wr * 64 + m * 16 + fr; const int t = (row - 2048) & 2047; const int pos = (cb < 64) ? (t >> 6) : (t & 63); const int idx = cb & 63;
                    cc[m][0] = *(const f32x4*)(ropec + pos * 64 + idx); cc[m][1] = *(const f32x4*)(ropec + pos * 64 + idx + 4); ss[m][0] = *(const f32x4*)(ropes + pos * 64 + idx); ss[m][1] = *(const f32x4*)(ropes + pos * 64 + idx + 4); }
            }
#pragma unroll
            for (int m = 0; m < 4; ++m) {
                const int row = u.pm * BM + ai * HALF + wr * 64 + m * 16 + fr;
                f32x4 a0 = acc[ai][0][m][0], a1 = acc[ai][0][m][1], b0 = acc[ai][1][m][0], b1 = acc[ai][1][m][1];
                if (rot) {
                    const f32x4 c0 = cc[m][0] * ksc, s0 = ss[m][0] * ksc, c1 = cc[m][1] * ksc, s1 = ss[m][1] * ksc;
                    const f32x4 na0 = a0 * c0 - b0 * s0, nb0 = a0 * s0 + b0 * c0, na1 = a1 * c1 - b1 * s1, nb1 = a1 * s1 + b1 * c1; a0 = na0; b0 = nb0; a1 = na1; b1 = nb1;
                } else if (isk) { a0 = a0 * ksc; a1 = a1 * ksc; b0 = b0 * ksc; b1 = b1 * ksc; }
                bf16_t* rowp = P + (size_t)row * 6144 + pn * BM + cb;
                *(u32x4*)(rowp) = pack8(a0, a1); *(u32x4*)(rowp + HALF) = pack8(b0, b1);
            }
        }
    }
};
struct EpiGlaIn {
    static constexpr bool PERM = true, AFTER_DRAIN = false;
    bf16_t* P; float* AF;
    __device__ __forceinline__ void operator()(const f32x4 (&acc)[2][2][4][2], const Unit& u, int wr, int wc, int fr, int fq) const {
        const int pn = u.pn; const float sc = (pn < 2) ? 0.08838834764831845f : 1.0f;
        const int cb = wc * 32 + 8 * fq;
#pragma unroll
        for (int ai = 0; ai < 2; ++ai)
#pragma unroll
            for (int m = 0; m < 4; ++m) {
                const int row = u.pm * BM + ai * HALF + wr * 64 + m * 16 + fr;
                const f32x4 a0 = acc[ai][0][m][0] * sc, a1 = acc[ai][0][m][1] * sc, b0 = acc[ai][1][m][0] * sc, b1 = acc[ai][1][m][1] * sc;
                bf16_t* rowp = P + (size_t)row * 3328 + pn * BM + cb;
                *(u32x4*)(rowp) = pack8(a0, a1); *(u32x4*)(rowp + HALF) = pack8(b0, b1);
                if (pn == 12 && cb < 32) { float* ap = AF + (size_t)row * 32 + cb; *(f32x4*)ap = a0; *(f32x4*)(ap + 4) = a1; }
            }
    }
};
struct EpiResid {
    static constexpr bool PERM = true, AFTER_DRAIN = false;
    bf16_t* TOK; const float* rd; const float* rd_ctx; const float* gate; int row_off; bf16_t* PS; int ncp;
    __device__ __forceinline__ void operator()(const f32x4 (&acc)[2][2][4][2], const Unit& u, int wr, int wc, int fr, int fq) const {
        const int rt = row_off + u.pm * BM; const int col0 = u.pn * BM + wc * 32 + 8 * fq;
        if (u.pm < ncp) {
            bf16_t* pb = PS + ((size_t)u.ks * 2048 + rt) * 1024 + col0;
#pragma unroll
            for (int ai = 0; ai < 2; ++ai)
#pragma unroll
                for (int m = 0; m < 4; ++m) { bf16_t* rowp = pb + (size_t)(ai * HALF + wr * 64 + m * 16 + fr) * 1024;
#pragma unroll
                    for (int bj = 0; bj < 2; ++bj) *(u32x4*)(rowp + bj * HALF) = pack8(acc[ai][bj][m][0], acc[ai][bj][m][1]); }
            return;
        }
        const int s = (rt < 2048) ? 8 : ((rt - 2048) >> 11);
        const float* gp = gate + s * 6144 + col0; const float* rb = (rt < 2048) ? rd_ctx : rd;
        f32x4 gv[2][2];
#pragma unroll
        for (int bj = 0; bj < 2; ++bj)
#pragma unroll
            for (int n = 0; n < 2; ++n) gv[bj][n] = *(const f32x4*)(gp + bj * HALF + n * 4);
#pragma unroll
        for (int ai = 0; ai < 2; ++ai) {
            if (rb) {
                f32x4 o0[4][2], o1[4][2];
#pragma unroll
                for (int m = 0; m < 4; ++m)
#pragma unroll
                    for (int bj = 0; bj < 2; ++bj) { const size_t o = (size_t)(rt + ai * HALF + wr * 64 + m * 16 + fr) * 1024 + col0 + bj * HALF; o0[m][bj] = *(const f32x4*)(rb + o); o1[m][bj] = *(const f32x4*)(rb + o + 4); }
#pragma unroll
                for (int m = 0; m < 4; ++m)
#pragma unroll
                    for (int bj = 0; bj < 2; ++bj) { const size_t o = (size_t)(rt + ai * HALF + wr * 64 + m * 16 + fr) * 1024 + col0 + bj * HALF;
                        *(u32x4*)(TOK + o) = pack8(o0[m][bj] + gv[bj][0] * acc[ai][bj][m][0], o1[m][bj] + gv[bj][1] * acc[ai][bj][m][1]); }
            } else {
                u32x4 w[4][2];
#pragma unroll
                for (int m = 0; m < 4; ++m)
#pragma unroll
                    for (int bj = 0; bj < 2; ++bj) w[m][bj] = *(const u32x4*)(TOK + (size_t)(rt + ai * HALF + wr * 64 + m * 16 + fr) * 1024 + col0 + bj * HALF);
#pragma unroll
                for (int m = 0; m < 4; ++m)
#pragma unroll
                    for (int bj = 0; bj < 2; ++bj) { const size_t o = (size_t)(rt + ai * HALF + wr * 64 + m * 16 + fr) * 1024 + col0 + bj * HALF; const u32x4 ww = w[m][bj]; f32x4 o0, o1;
                        o0[0] = __uint_as_float(ww.x << 16); o0[1] = __uint_as_float(ww.x & 0xffff0000u); o0[2] = __uint_as_float(ww.y << 16); o0[3] = __uint_as_float(ww.y & 0xffff0000u);
                        o1[0] = __uint_as_float(ww.z << 16); o1[1] = __uint_as_float(ww.z & 0xffff0000u); o1[2] = __uint_as_float(ww.w << 16); o1[3] = __uint_as_float(ww.w & 0xffff0000u);
                        *(u32x4*)(TOK + o) = pack8(o0 + gv[bj][0] * acc[ai][bj][m][0], o1 + gv[bj][1] * acc[ai][bj][m][1]); }
            }
        }
    }
};
template <bool TWICE> __device__ __forceinline__ f32x4 swiglu4(const f32x4 g, const f32x4 u) {
    const f32x4 t = g * -1.4426950408889634f; f32x4 ex, r;
#pragma unroll
    for (int j = 0; j < 4; ++j) ex[j] = __builtin_amdgcn_exp2f(t[j]);
    const f32x4 d = TWICE ? ex * 0.5f + 0.5f : ex + 1.0f;
#pragma unroll
    for (int j = 0; j < 4; ++j) r[j] = __builtin_amdgcn_rcpf(d[j]);
    return (g * u) * r;
}
struct EpiSwiglu {
    static constexpr bool PERM = true, AFTER_DRAIN = false;
    bf16_t* H; int ldh;
    __device__ __forceinline__ void operator()(const f32x4 (&acc)[2][2][4][2], const Unit& u, int wr, int wc, int fr, int fq) const {
        const int cb = u.pn * HALF + wc * 32 + 8 * fq;
#pragma unroll
        for (int ai = 0; ai < 2; ++ai)
#pragma unroll
            for (int m = 0; m < 4; ++m) {
                const int row = u.pm * BM + ai * HALF + wr * 64 + m * 16 + fr;
                const f32x4 h0 = swiglu4<false>(acc[ai][0][m][0], acc[ai][1][m][0]), h1 = swiglu4<false>(acc[ai][0][m][1], acc[ai][1][m][1]);
                *(u32x4*)(H + (size_t)row * ldh + cb) = pack8(h0, h1);
            }
    }
};
__device__ __forceinline__ unsigned pack4_fp8(float a, float b, float c, float d) {
    int li_ = 0x43e00000; asm volatile("" : "+s"(li_)); const float lim = __builtin_bit_cast(float, li_);
    a = __builtin_amdgcn_fmed3f(a, -lim, lim); b = __builtin_amdgcn_fmed3f(b, -lim, lim); c = __builtin_amdgcn_fmed3f(c, -lim, lim); d = __builtin_amdgcn_fmed3f(d, -lim, lim);
    int w = 0; w = __builtin_amdgcn_cvt_pk_fp8_f32(a, b, w, false); w = __builtin_amdgcn_cvt_pk_fp8_f32(c, d, w, true); return (unsigned)w; }
struct EpiSwigluF8 {
    static constexpr bool PERM = true, AFTER_DRAIN = false;
    unsigned char* H; int ldh;
    __device__ __forceinline__ void operator()(const f32x4 (&acc)[2][2][4][2], const Unit& u, int wr, int wc, int fr, int fq) const {
        const int cb = u.pn * HALF + wc * 32 + 8 * fq;
#pragma unroll
        for (int ai = 0; ai < 2; ++ai)
#pragma unroll
            for (int m = 0; m < 4; ++m) {
                const int row = u.pm * BM + ai * HALF + wr * 64 + m * 16 + fr;
                const f32x4 h0 = swiglu4<true>(acc[ai][0][m][0], acc[ai][1][m][0]), h1 = swiglu4<true>(acc[ai][0][m][1], acc[ai][1][m][1]);
                typedef unsigned u32x2e __attribute__((ext_vector_type(2))); u32x2e o; o.x = pack4_fp8(h0[0], h0[1], h0[2], h0[3]); o.y = pack4_fp8(h1[0], h1[1], h1[2], h1[3]);
                *(u32x2e*)(H + (size_t)row * ldh + cb) = o;
            }
    }
};
struct EpiNull {
    static constexpr bool PERM = true, AFTER_DRAIN = false;
    __device__ __forceinline__ void operator()(const f32x4 (&acc)[2][2][4][2], const Unit& u, int wr, int wc, int fr, int fq) const {
#pragma unroll
        for (int ai = 0; ai < 2; ++ai)
#pragma unroll
            for (int m = 0; m < 4; ++m) asm volatile("" :: "v"(acc[ai][0][m][0]), "v"(acc[ai][0][m][1]), "v"(acc[ai][1][m][0]), "v"(acc[ai][1][m][1])); }
};
constexpr int MOE_KSPLIT_E = 1;
struct EpiMoeDown {
    static constexpr bool PERM = true, AFTER_DRAIN = false;
    bf16_t* YB; const int* rowinfo; const float* roww;
    __device__ __forceinline__ void operator()(const f32x4 (&acc)[2][2][4][2], const Unit& u, int wr, int wc, int fr, int fq) const {
        const int col0 = u.pn * BM + wc * 32 + 8 * fq;
        int info[8]; float w[8];
#pragma unroll
        for (int i = 0; i < 8; ++i) { const int p = (i >> 2) * HALF + wr * 64 + (i & 3) * 16 + fr, R = u.pm * BM + p + u.fix; const bool ok = p < u.lim; info[i] = ok ? rowinfo[R] : -1; w[i] = ok ? roww[R] : 0.f; }
#pragma unroll
        for (int ai = 0; ai < 2; ++ai)
#pragma unroll
            for (int m = 0; m < 4; ++m) { const int i = ai * 4 + m;
                if (info[i] >= 0) { bf16_t* rowp = YB + ((size_t)info[i] * MOE_KSPLIT_E + u.ks) * 1024 + col0;
#pragma unroll
                    for (int bj = 0; bj < 2; ++bj) *(u32x4*)(rowp + bj * HALF) = pack8(acc[ai][bj][m][0] * w[i], acc[ai][bj][m][1] * w[i]); } }
    }
};
struct MoeOrder {
    int nM, nN, nwg, G, c, nsplit, ntf; int poff[9]; int cnt[8]; int cap;
    __device__ __forceinline__ bool next(int i, Unit& u) const {
        const long L = (long)i * G + c; if (L >= nwg) return false;
        int wgid = (int)L; { const int q = nwg / NXCD, r = nwg % NXCD, xcd = wgid % NXCD, off = wgid / NXCD; wgid = (xcd < r ? xcd * (q + 1) : r * (q + 1) + (xcd - r) * q) + off; }
        const int nNv = nN * nsplit, nig = WGM * nNv, gid = wgid / nig, fm = gid * WGM, gsz = (nM - fm) < WGM ? (nM - fm) : WGM;
        u.pm = fm + ((wgid % nig) % gsz); const int pv = (wgid % nig) / gsz; u.pn = pv / nsplit; u.ks = pv % nsplit; u.nt = ntf / nsplit; u.koff = u.ks * u.nt * BK;
        int e = 0, pe = 0, ce = 0;
#pragma unroll
        for (int k = 1; k < 8; ++k) e += (u.pm >= poff[k]) ? 1 : 0;
#pragma unroll
        for (int k = 0; k < 8; ++k) { pe += (e == k) ? poff[k] : 0; ce += (e == k) ? cnt[k] : 0; }
        u.pb = e * nN + u.pn; u.fix = e * cap - pe * BM; u.lim = ce - (u.pm - pe) * BM; return true;
    }
    __device__ __forceinline__ void a_ready(const Unit&) const {}
    __device__ __forceinline__ void done(const Unit&) const {}
};


struct ResidOrder {
    StaticOrder so; int ncp, nsub, S, pairs;
    __device__ __forceinline__ void init(int M, int N, int G_, int c_, int K_, int ncp_, int S_) { ncp = ncp_; S = S_; pairs = K_ / 128; so.init(M - ncp_ * BM, N, G_, c_, K_); nsub = ncp_ * (N / BM) * S_; }
    __device__ __forceinline__ bool next(int i, Unit& u) const {
        if (so.next(i, u)) { u.pm += ncp; return true; }
        const long Ls = (long)i * so.G + so.c - so.nwg; if (Ls >= nsub) return false;
        const int ks = (int)(Ls % S), r = (int)(Ls / S); u.pn = r % so.nN; u.pm = r / so.nN; u.pb = u.pn; u.ks = ks; u.fix = 0; u.lim = 0;
        const int base = pairs / S, rem = pairs % S; const int start = ks < rem ? ks * (base + 1) : rem * (base + 1) + (ks - rem) * base;
        u.koff = 128 * start; u.nt = 2 * (base + (ks < rem ? 1 : 0)); return true;
    }
    __device__ __forceinline__ void a_ready(const Unit&) const {}
    __device__ __forceinline__ void done(const Unit&) const {}
};

template <class Epi, class Sched, bool ALIGN_EPI = false, bool SP2 = false, bool FP8 = false, bool GATHER = false>
__device__ __forceinline__ void gemm_phase(PG8_LAS unsigned char* lds, const Gemm g, const Sched& S, const Epi& E, int tid_) {
    const int tid = tid_, wid = __builtin_amdgcn_readfirstlane(tid >> 6), lane = tid & 63, wr = wid >> 2, wc = wid & 3, fr = lane & 15, fq = lane >> 4;
    int sw_v = (int)g.sw, sx_v = (int)g.sx;
    if constexpr (FP8) { int s0_ = sw_v, s1_ = sx_v; asm volatile("" : "+s"(s0_), "+s"(s1_)); sw_v = s0_; sx_v = s1_; }
    const int K = g.K;
    unsigned voffA[2], voffB[2];
#pragma unroll
    for (int i = 0; i < 2; ++i) { int R, C; stage_rc(tid * 16 + i * 8192, R, C); const int Rb = Epi::PERM ? ((R & ~31) + perm32(R & 31)) : R;
        voffA[i] = (unsigned)(R * K + C) * 2u; voffB[i] = (unsigned)(Rb * K + C) * 2u; }
    const size_t kstep = (size_t)(BK * 2);
    const size_t hstep = (size_t)HALF * K * 2;
    const size_t tstep = 2 * hstep;
    const unsigned ldsw = (unsigned)wid * 1024u;
    const int aoff = lds_byte(wr * 64 + fr, fq * 8), boff = lds_byte(wc * 32 + fr, fq * 8);
#define PG8_SA(b, h) (((b) * 2 + (h)) * HTB)
#define PG8_SB(b, h) ((4 + (b) * 2 + (h)) * HTB)
#define PG8_STAGE(bufoff, gbase, voff) do { _Pragma("unroll") for (int _i = 0; _i < 2; ++_i) \
        __builtin_amdgcn_global_load_lds((const unsigned*)((const char*)(gbase) + (voff)[_i]), (PG8_LAS unsigned*)(lds + (bufoff) + ldsw + _i * 8192), 16, 0, 0); } while (0)
#define PG8_STA(bufoff, base, h, OFF) do { if constexpr (GATHER) PG8_STAGE(bufoff, base, OFF[h]); else PG8_STAGE(bufoff, (base) + (h) * hstep, voffA); } while (0)
#define PG8_GLOAD(dst, U) do { _Pragma("unroll") for (int h_ = 0; h_ < 2; ++h_) _Pragma("unroll") for (int i_ = 0; i_ < 2; ++i_) { int R_, C_; stage_rc(tid * 16 + i_ * 8192, R_, C_); const int p_ = h_ * HALF + R_; \
        dst[h_][i_] = (p_ < (U).lim) ? g.gidx[(U).pm * BM + p_ + (U).fix] : 0; } } while (0)
#define PG8_GOFF(dst, raw) do { _Pragma("unroll") for (int h_ = 0; h_ < 2; ++h_) _Pragma("unroll") for (int i_ = 0; i_ < 2; ++i_) { int R_, C_; stage_rc(tid * 16 + i_ * 8192, R_, C_); \
        dst[h_][i_] = ((unsigned)(raw[h_][i_] >> 1) * (unsigned)K + (unsigned)C_) * 2u; } } while (0)
#define PG8_LDA(dst, b, h) do { _Pragma("unroll") for (int m = 0; m < 4; ++m) _Pragma("unroll") for (int k = 0; k < 2; ++k) dst[m][k] = *(const PG8_LAS bf16x8*)(lds + PG8_SA(b, h) + aoff + m * 2048 + k * 1024); } while (0)
#define PG8_LDB(dst, b, h) do { _Pragma("unroll") for (int n = 0; n < 2; ++n) _Pragma("unroll") for (int k = 0; k < 2; ++k) dst[n][k] = *(const PG8_LAS bf16x8*)(lds + PG8_SB(b, h) + boff + n * 2048 + k * 1024); } while (0)
#define PG8_CAT(x, y) __builtin_shufflevector(__builtin_bit_cast(i32x4_t, (x)), __builtin_bit_cast(i32x4_t, (y)), 0, 1, 2, 3, 4, 5, 6, 7)
#define PG8_MMA(ai, bj, At, Bt) do { __builtin_amdgcn_s_setprio(1); _Pragma("unroll") for (int m = 0; m < 4; ++m) _Pragma("unroll") for (int n = 0; n < 2; ++n) { \
        if constexpr (FP8) { const i32x8_t a8_ = PG8_CAT(Bt[n][0], Bt[n][1]), b8_ = PG8_CAT(At[m][0], At[m][1]);     \
            asm volatile("v_mfma_scale_f32_16x16x128_f8f6f4 %0, %1, %2, %0, %3, %4 op_sel_hi:[0,0,0]" : "+v"(acc[ai][bj][m][n]) : "v"(a8_), "v"(b8_), "v"(sw_v), "v"(sx_v)); } \
        else { _Pragma("unroll") for (int k = 0; k < 2; ++k) acc[ai][bj][m][n] = __builtin_amdgcn_mfma_f32_16x16x32_bf16(Bt[n][k], At[m][k], acc[ai][bj][m][n], 0, 0, 0); } } __builtin_amdgcn_s_setprio(0); } while (0)
#define PG8_WAIT_V(n) asm volatile("s_waitcnt vmcnt(" #n ")" ::: "memory")
#define PG8_WAIT_L(n) asm volatile("s_waitcnt lgkmcnt(" #n ")" ::: "memory")
#define PG8_BAR __builtin_amdgcn_s_barrier()
#define PG8_SCHED __builtin_amdgcn_sched_barrier(0)
    Unit cur, nxt, nn; int ui = 0;
    if (!S.next(0, cur)) return;
    unsigned cv[2][2], nv[2][2], sel[2][2]; int raw[2][2];
    f32x4 acc[2][2][4][2];
#pragma unroll
    for (int a = 0; a < 2; ++a)
#pragma unroll
        for (int b = 0; b < 2; ++b)
#pragma unroll
            for (int m = 0; m < 4; ++m)
#pragma unroll
                for (int n = 0; n < 2; ++n) acc[a][b][m][n] = (f32x4){0.f, 0.f, 0.f, 0.f};
    bf16x8 At[4][2], B0[2][2], B1[2][2];
    const char* cA = (const char*)g.A + (GATHER ? (size_t)0 : (size_t)cur.pm * tstep) + (size_t)cur.koff * 2; const char* cB = (const char*)g.Bt + (size_t)cur.pb * tstep + (size_t)cur.koff * 2;
    S.a_ready(cur);
    if constexpr (GATHER) { PG8_GLOAD(raw, cur); PG8_GOFF(cv, raw);
        if (S.next(1, nxt)) { PG8_GLOAD(raw, nxt); PG8_GOFF(nv, raw); } else { _Pragma("unroll") for (int h_ = 0; h_ < 2; ++h_) _Pragma("unroll") for (int i_ = 0; i_ < 2; ++i_) nv[h_][i_] = cv[h_][i_]; } }
    if constexpr (SP2) {
        PG8_STAGE(PG8_SB(0, 0), cB, voffB); PG8_STAGE(PG8_SB(0, 1), cB + hstep, voffB); PG8_STA(PG8_SA(0, 0), cA, 0, cv); PG8_STA(PG8_SA(0, 1), cA, 1, cv);
        if (wr == 1) PG8_BAR;
        PG8_WAIT_V(2); PG8_BAR;
        PG8_STAGE(PG8_SB(1, 0), cB + kstep, voffB); PG8_STA(PG8_SA(1, 0), cA + kstep, 0, cv); PG8_STAGE(PG8_SB(1, 1), cB + hstep + kstep, voffB);
        PG8_WAIT_V(6); PG8_BAR;
    } else {
        PG8_STAGE(PG8_SB(0, 0), cB, voffB); PG8_STAGE(PG8_SA(0, 0), cA, voffA); PG8_STAGE(PG8_SB(0, 1), cB + hstep, voffB); PG8_STAGE(PG8_SA(0, 1), cA + hstep, voffA);
        if (wr == 1) PG8_BAR;
        PG8_WAIT_V(4); PG8_BAR;
        PG8_STAGE(PG8_SB(1, 0), cB + kstep, voffB); PG8_STAGE(PG8_SA(1, 0), cA + kstep, voffA); PG8_STAGE(PG8_SB(1, 1), cB + hstep + kstep, voffB);
        PG8_WAIT_V(6); PG8_BAR;
    }
    for (;;) {
        const bool has_next = S.next(ui + 1, nxt);
        const char* nA = has_next ? (const char*)g.A + (GATHER ? (size_t)0 : (size_t)nxt.pm * tstep) + (size_t)nxt.koff * 2 : cA; const char* nB = has_next ? (const char*)g.Bt + (size_t)nxt.pb * tstep + (size_t)nxt.koff * 2 : cB;
        const int nt = cur.nt;
        for (int t = 0; t < nt; t += 2) {
            const bool last = (t == nt - 2);
            const char* a1 = cA + (size_t)(t + 1) * kstep;
            const char* a2 = last ? nA : cA + (size_t)(t + 2) * kstep; const char* b2 = last ? nB : cB + (size_t)(t + 2) * kstep;
            const char* a3 = a2 + kstep; const char* b3 = b2 + kstep;
            if (last && has_next) S.a_ready(nxt);
            if constexpr (GATHER) { _Pragma("unroll") for (int h_ = 0; h_ < 2; ++h_) _Pragma("unroll") for (int i_ = 0; i_ < 2; ++i_) sel[h_][i_] = last ? nv[h_][i_] : cv[h_][i_]; }
            if constexpr (SP2) {
            PG8_LDB(B0, 0, 0); PG8_LDB(B1, 0, 1); PG8_SCHED; PG8_LDA(At, 0, 0); PG8_STA(PG8_SA(1, 1), a1, 1, cv);
            PG8_WAIT_V(8); PG8_WAIT_L(0); PG8_BAR; PG8_MMA(0, 0, At, B0); PG8_MMA(0, 1, At, B1); PG8_BAR; PG8_SCHED;
            PG8_LDA(At, 0, 1); PG8_STAGE(PG8_SB(0, 0), b2, voffB); PG8_STAGE(PG8_SB(0, 1), b2 + hstep, voffB); PG8_STA(PG8_SA(0, 0), a2, 0, sel);
            PG8_WAIT_V(8); PG8_WAIT_L(0); PG8_BAR; PG8_MMA(1, 0, At, B0); PG8_MMA(1, 1, At, B1); PG8_BAR; PG8_SCHED;
            PG8_LDB(B0, 1, 0); PG8_LDB(B1, 1, 1); PG8_SCHED; PG8_LDA(At, 1, 0); PG8_STA(PG8_SA(0, 1), a2, 1, sel);
            PG8_WAIT_V(8); PG8_WAIT_L(0); PG8_BAR; PG8_MMA(0, 0, At, B0); PG8_MMA(0, 1, At, B1); PG8_BAR; PG8_SCHED;
            PG8_LDA(At, 1, 1); PG8_STAGE(PG8_SB(1, 0), b3, voffB); PG8_STAGE(PG8_SB(1, 1), b3 + hstep, voffB); PG8_STA(PG8_SA(1, 0), a3, 0, sel);
            PG8_WAIT_V(8); PG8_WAIT_L(0); PG8_BAR; PG8_MMA(1, 0, At, B0); PG8_MMA(1, 1, At, B1); PG8_BAR; PG8_SCHED;
            } else {
            PG8_LDB(B0, 0, 0); PG8_SCHED; PG8_LDA(At, 0, 0); PG8_STAGE(PG8_SA(1, 1), a1 + hstep, voffA);
            PG8_WAIT_L(8); PG8_BAR; PG8_WAIT_L(0); PG8_MMA(0, 0, At, B0); PG8_BAR; PG8_SCHED;
            PG8_LDB(B1, 0, 1); PG8_STAGE(PG8_SB(0, 0), b2, voffB);
            PG8_BAR; PG8_WAIT_L(0); PG8_MMA(0, 1, At, B1); PG8_BAR;
            PG8_LDA(At, 0, 1); PG8_STAGE(PG8_SA(0, 0), a2, voffA);
            PG8_BAR; PG8_WAIT_L(0); PG8_MMA(1, 0, At, B0); PG8_BAR; PG8_SCHED;
            PG8_STAGE(PG8_SB(0, 1), b2 + hstep, voffB);
            PG8_WAIT_V(6); PG8_BAR; PG8_MMA(1, 1, At, B1); PG8_BAR;
            PG8_LDB(B0, 1, 0); PG8_SCHED; PG8_LDA(At, 1, 0); PG8_STAGE(PG8_SA(0, 1), a2 + hstep, voffA);
            PG8_WAIT_L(8); PG8_BAR; PG8_WAIT_L(0); PG8_MMA(0, 0, At, B0); PG8_BAR; PG8_SCHED;
            PG8_LDB(B1, 1, 1); PG8_STAGE(PG8_SB(1, 0), b3, voffB);
            PG8_BAR; PG8_WAIT_L(0); PG8_MMA(0, 1, At, B1); PG8_BAR;
            PG8_LDA(At, 1, 1); PG8_STAGE(PG8_SA(1, 0), a3, voffA);
            PG8_BAR; PG8_WAIT_L(0); PG8_MMA(1, 0, At, B0); PG8_BAR; PG8_SCHED;
            PG8_STAGE(PG8_SB(1, 1), b3 + hstep, voffB);
            PG8_WAIT_V(6); PG8_BAR; PG8_MMA(1, 1, At, B1); PG8_BAR;
            }
        }
        if constexpr (ALIGN_EPI) { if (wr == 0) PG8_BAR; }
        bool has_nn = false;
        if constexpr (GATHER) { static_assert(SP2, "GATHER is written for the SP2 loop"); has_nn = has_next && S.next(ui + 2, nn); if (has_nn) PG8_GLOAD(raw, nn); }
        if constexpr (FP8) asm volatile("s_nop 15\n\ts_nop 15" ::: "memory");
        if constexpr (!Epi::AFTER_DRAIN) { int tz = tid; asm volatile("" : "+v"(tz));
            const int lz = tz & 63, wz = __builtin_amdgcn_readfirstlane(tz >> 6); E(acc, cur, wz >> 2, wz & 3, lz & 15, lz >> 4); S.done(cur); }
        if (!has_next) break;
#pragma unroll
        for (int a = 0; a < 2; ++a)
#pragma unroll
            for (int b = 0; b < 2; ++b)
#pragma unroll
                for (int m = 0; m < 4; ++m)
#pragma unroll
                    for (int n = 0; n < 2; ++n) acc[a][b][m][n] = (f32x4){0.f, 0.f, 0.f, 0.f};
        cur = nxt; cA = nA; cB = nB; ++ui;
        if constexpr (GATHER) { _Pragma("unroll") for (int h_ = 0; h_ < 2; ++h_) _Pragma("unroll") for (int i_ = 0; i_ < 2; ++i_) cv[h_][i_] = nv[h_][i_];
            if (has_nn) PG8_GOFF(nv, raw); }
        if constexpr (ALIGN_EPI) { if (wr == 1) PG8_BAR; }
    }
    PG8_WAIT_V(0);
    if constexpr (!ALIGN_EPI) { if (wr == 0) PG8_BAR; }
    PG8_BAR;
    if constexpr (Epi::AFTER_DRAIN) { E.fused(acc, cur, wr, wc, fr, fq, lds, wid, lane); S.done(cur); }
#undef PG8_SA
#undef PG8_SB
#undef PG8_STAGE
#undef PG8_LDA
#undef PG8_STA
#undef PG8_GLOAD
#undef PG8_GOFF
#undef PG8_LDB
#undef PG8_MMA
#undef PG8_CAT
#undef PG8_WAIT_V
#undef PG8_WAIT_L
#undef PG8_BAR
#undef PG8_SCHED
}
}

constexpr int NWAVES = 8;
constexpr int D = 1024, NB = 8, SEQ = 2048, CTXL = 256, DEPTH = 4;
constexpr int NCTX = NB * CTXL, NLAT = NB * SEQ, NTOK = NCTX + NLAT;
constexpr int RET_IN = 6144, GLA_IN = 3104, GLA_INP = 3328, DFF = 2816, NE = 8, DFFE = 3584;
constexpr int MAXROWS = 2 * NTOK + NE * 256;
constexpr float EPS = 1e-6f;
constexpr int MOE_KSPLIT = 1;

constexpr size_t MiB = 1u << 20;
constexpr size_t WS_CTL = 0, CTL_ZERO_BYTES = 64 * 1024;
constexpr size_t WS_MODS = 1 * MiB;
constexpr size_t WS_ROPE = 2 * MiB;
constexpr size_t WS_TIE = 3 * MiB, WS_TIP0 = WS_TIE + 128 * 1024, WS_TIP1 = WS_TIE + 256 * 1024, WS_TIW = WS_TIE + 384 * 1024;
constexpr size_t WS_RINFO = WS_TIE, WS_RW = 7 * MiB;
constexpr size_t WS_AF = 4 * MiB;
constexpr size_t WS_TOK = 8 * MiB;
constexpr size_t WS_HA = 80 * MiB;
constexpr size_t WS_WRET = 116 * MiB;
constexpr size_t WR_IN = 0, WR_OUT = 12 * MiB, WR_GU = 16 * MiB, WR_DN = 27 * MiB;
constexpr size_t WS_WGLA = 150 * MiB;
constexpr size_t WG_IN = 0, WG_OUT = 7 * MiB, WG_GU = 9 * MiB, WG_DN = 121 * MiB;
constexpr size_t WS_SCR = 328 * MiB;
constexpr size_t WS_P = WS_SCR, WS_OF = WS_SCR + 216 * MiB, WS_OB = WS_SCR + 288 * MiB, WS_A2 = WS_SCR + 360 * MiB;
constexpr size_t WS_QT = WS_SCR + 120 * MiB, WS_EB = WS_SCR + 192 * MiB;
constexpr size_t WS_HID = WS_SCR;
constexpr size_t WS_HIDG = WS_SCR, WS_AG = WS_SCR + 272 * MiB, WS_YB = WS_SCR + 360 * MiB;
constexpr size_t WS_PS = WS_SCR + 216 * MiB;
constexpr size_t WS_END = WS_YB + (size_t)144 * MOE_KSPLIT * MiB;
static_assert(WS_HIDG + (size_t)MAXROWS * DFFE * 2 <= WS_AG && WS_AG + (size_t)MAXROWS * D * 2 <= WS_YB, "MoE scratch map");
static_assert(WS_P + (size_t)NTOK * RET_IN * 2 <= WS_OF && WS_OF + (size_t)NTOK * 2048 * 2 <= WS_OB && WS_OB + (size_t)NTOK * 2048 * 2 <= WS_A2, "scratch map");
constexpr int CW_TMO = 0, CW_CODE = 1, CW_BAR = 4096, CW_GCNT = 8192, CW_CVTQ = 9216;

constexpr int LDS_BYTES = 147456;
constexpr int MISC_OFF = 147456 - 256;

#define GAS __attribute__((address_space(1)))
#define LAS __attribute__((address_space(3)))
#define DI __device__ __forceinline__
typedef unsigned short bf16;
typedef float f32x4 __attribute__((ext_vector_type(4)));
typedef float f32x2 __attribute__((ext_vector_type(2)));
typedef unsigned u32x4 __attribute__((ext_vector_type(4)));
typedef unsigned u32x2 __attribute__((ext_vector_type(2)));
#define LDS_WAIT() asm volatile("s_waitcnt lgkmcnt(0)" ::: "memory")
#define VM_WAIT() asm volatile("s_waitcnt vmcnt(0)" ::: "memory")
DI float bf_lo(unsigned w) { return __uint_as_float(w << 16); }
DI float bf_hi(unsigned w) { return __uint_as_float(w & 0xffff0000u); }
DI unsigned pk2(float lo, float hi) { return pg8::cvt_pk_bf16(lo, hi); }
DI float wave_sum(float v, int  ) {
#define WS_DPP(ctrl, rmask) v += __builtin_bit_cast(float, __builtin_amdgcn_update_dpp(0, __builtin_bit_cast(int, v), ctrl, rmask, 0xF, false))
    WS_DPP(0xB1, 0xF); WS_DPP(0x4E, 0xF); WS_DPP(0x141, 0xF); WS_DPP(0x140, 0xF); WS_DPP(0x142, 0xA); WS_DPP(0x143, 0xC);
#undef WS_DPP
    return __builtin_bit_cast(float, __builtin_amdgcn_readlane(__builtin_bit_cast(int, v), 63));
}
DI float silu(float x) { return x * __builtin_amdgcn_rcpf(1.0f + __builtin_amdgcn_exp2f(x * -1.4426950408889634f)); }

#define XB_TMO      128
#define XB_XCNT(j)  (256  + 64 * (j))
#define XB_XSUB(j)  (1280 + 64 * (j))
#define XB_XGEN(j)  (2304 + 64 * (j))
#define XB_TOP      3328
#define XB_TOPGEN   3392
#define XCD_BAR_WORDS 3456
#define XB_SPIN_CAP (1u << 18)

__device__ __forceinline__ unsigned xb_ld(unsigned* p)              { return __hip_atomic_load(p, __ATOMIC_RELAXED, __HIP_MEMORY_SCOPE_AGENT); }
__device__ __forceinline__ unsigned xb_add(unsigned* p, unsigned v) { return __hip_atomic_fetch_add(p, v, __ATOMIC_RELAXED, __HIP_MEMORY_SCOPE_AGENT); }
__device__ __forceinline__ unsigned xb_xcc_id() { return (unsigned)__builtin_amdgcn_s_getreg((3 << 11) | 20) & 0xFu; }
#define XB_SPIN(cond, bar) do { unsigned _sp = 0; while (cond) { __builtin_amdgcn_s_sleep(1); \
    if ((++_sp & 255u) == 0u) { if (xb_ld(&(bar)[XB_TMO])) break; if (_sp > XB_SPIN_CAP) { atomicAdd(&(bar)[XB_TMO], 1u); break; } } } } while (0)

struct XcdBarrier {
    unsigned* bar; unsigned x;
    volatile LAS unsigned* st;
};

__device__ __forceinline__ XcdBarrier xcd_barrier_post(unsigned* bar, volatile LAS unsigned* st) {
    XcdBarrier b; b.bar = bar; b.x = xb_xcc_id(); b.st = st;
    if (threadIdx.x == 0) (void)xb_add(&bar[XB_XCNT(b.x)], 1u);
    return b;
}
__device__ __forceinline__ void xcd_barrier_complete(unsigned* bar, unsigned x, unsigned& nloc, unsigned& nx) {
    const unsigned G = gridDim.x * gridDim.y * gridDim.z;
    unsigned sum, cnt, mine, sp = 0u;
    for (;;) {
        sum = 0u; cnt = 0u; mine = 0u;
#pragma unroll
        for (unsigned j = 0; j < 16; ++j) { const unsigned c = xb_ld(&bar[XB_XCNT(j)]); sum += c; cnt += (c > 0u) ? 1u : 0u; mine = (j == x) ? c : mine; }
        if (sum == G) break;
        __builtin_amdgcn_s_sleep(1);
        if ((++sp & 255u) == 0u) { if (xb_ld(&bar[XB_TMO])) break; if (sp > XB_SPIN_CAP) { atomicAdd(&bar[XB_TMO], 1u); break; } }
    }
    nloc = mine > 0u ? mine : 1u; nx = cnt > 0u ? cnt : 1u;
}

__device__ __forceinline__ void xcd_barrier(const XcdBarrier& b) {
    asm volatile("s_waitcnt vmcnt(0)" ::: "memory");
    __syncthreads();
    if (threadIdx.x == 0) {
        unsigned* bar = b.bar;
        __builtin_amdgcn_s_waitcnt(0);
        unsigned nloc = b.st[0], nx = b.st[1];
        if (nloc == 0u) { xcd_barrier_complete(bar, b.x, nloc, nx); b.st[0] = nloc; b.st[1] = nx; }
        const unsigned old = xb_add(&bar[XB_XSUB(b.x)], 1u);
        const unsigned gen = old / nloc;
        if (old + 1u == (gen + 1u) * nloc) {
            __builtin_amdgcn_fence(__ATOMIC_RELEASE, "agent");
            asm volatile("s_waitcnt vmcnt(0)" ::: "memory");
            const unsigned og = xb_add(&bar[XB_TOP], 1u);
            const unsigned tg = og / nx;
            if (og + 1u == (tg + 1u) * nx) xb_add(&bar[XB_TOPGEN], 1u);
            else XB_SPIN(xb_ld(&bar[XB_TOPGEN]) == tg, bar);
            __builtin_amdgcn_fence(__ATOMIC_ACQUIRE, "agent");
            xb_add(&bar[XB_XGEN(b.x)], 1u);
            asm volatile("s_waitcnt vmcnt(0)" ::: "memory");
        } else {
            XB_SPIN(xb_ld(&bar[XB_XGEN(b.x)]) == gen, bar);
            __builtin_amdgcn_fence(__ATOMIC_ACQUIRE, "agent");
            asm volatile("s_waitcnt vmcnt(0)" ::: "memory");
        }
    }
    __syncthreads();
}

struct Args { const float* in[26]; float* out; unsigned char* ws; int lo, hi; };
struct Frame {
    LAS unsigned char* lds;
    int tid, lane, wave, G, gw, NGW;
    unsigned char* ws;
    const __attribute__((address_space(4))) struct Args* ap;
    float* out;
};
enum { I_X = 0, I_C, I_CTX, I_CCTX, I_ADAW, I_ADAB, I_NMIX, I_NFFN, I_FING, I_RWIN, I_RDEC, I_RGNW, I_RGNB, I_RWOUT, I_GWIN, I_GWUP, I_GBG, I_GNG, I_GWOUT,
       I_FWG, I_FWU, I_FWD, I_MWR, I_MWG, I_MWU, I_MWD };

struct Src { const float* p; int ld; int nvalid; };
DI void cvt_tile(Frame& F, const Src s, int k0, bf16* dst  , int K, LAS unsigned* scr) {
    const int lane = F.lane;
    float v[64];
    const bool ok = lane < s.nvalid;
    const float* p = s.p + (size_t)k0 * s.ld + (ok ? lane : 0);
#pragma unroll
    for (int i = 0; i < 64; ++i) v[i] = __builtin_nontemporal_load(p + (size_t)i * s.ld);
#pragma unroll
    for (int i = 0; i < 64; ++i) v[i] = ok ? v[i] : 0.f;
#pragma unroll
    for (int i = 0; i < 32; ++i) scr[lane * 33 + i] = pk2(v[2 * i], v[2 * i + 1]);
    LDS_WAIT();
#pragma unroll
    for (int j = 0; j < 8; ++j) { const int n = (lane >> 3) + 8 * j, c = lane & 7; const LAS unsigned* q = scr + n * 33 + 4 * c;
        u32x4 o; o.x = q[0]; o.y = q[1]; o.z = q[2]; o.w = q[3];
        *(u32x4*)(dst + (size_t)n * K + k0 + 8 * c) = o; }
    LDS_WAIT();
}
DI void cvt_tile_f8(Frame& F, const Src s, int k0, unsigned char* dst, int Kb, float scale, LAS unsigned* scr) {
    const int lane = F.lane;
    float v[64];
    const bool ok = lane < s.nvalid;
    const float* p = s.p + (size_t)k0 * s.ld + (ok ? lane : 0);
#pragma unroll
    for (int i = 0; i < 64; ++i) v[i] = __builtin_nontemporal_load(p + (size_t)i * s.ld);
#pragma unroll
    for (int i = 0; i < 64; ++i) v[i] = ok ? v[i] * scale : 0.f;
#pragma unroll
    for (int i = 0; i < 16; ++i) scr[lane * 17 + i] = pg8::pack4_fp8(v[4 * i], v[4 * i + 1], v[4 * i + 2], v[4 * i + 3]);
    LDS_WAIT();
#pragma unroll
    for (int j = 0; j < 4; ++j) { const int n = (lane >> 2) + 16 * j, c = lane & 3; const LAS unsigned* q = scr + n * 17 + 4 * c;
        u32x4 o; o.x = q[0]; o.y = q[1]; o.z = q[2]; o.w = q[3];
        __builtin_nontemporal_store(o, (u32x4*)(dst + (size_t)n * Kb + k0 + 16 * c)); }
    LDS_WAIT();
}
DI int ret_qk_src_col(int n0) { const int blk = (n0 & 255) >> 6; const int sblk = (blk == 1) ? 2 : (blk == 2 ? 1 : blk); return (n0 & ~255) + sblk * 64; }
#ifndef CVT_FILL_WAVES
#define CVT_FILL_WAVES 0
#endif
constexpr float MOE_WGU_SCALE = 64.f, MOE_WDN_SCALE = 128.f;
constexpr unsigned E8M0_1 = 0x7f7f7f7fu, E8M0_2M1 = 0x7e7e7e7eu, E8M0_2M6 = 0x79797979u, E8M0_2M7 = 0x78787878u;
constexpr int CVT_RET_ITEMS = 16 * 96 + 32 * 16 + 16 * 88 + 44 * 16, CVT_GLA_ITEMS = 16 * 52 + 16 * 16 + 8 * 16 * 112 + 8 * 56 * 16;
DI void cvt_ret_item(Frame& F, int j, int r, LAS unsigned* scr) {
    bf16* W = (bf16*)(F.ws + WS_WRET);
    constexpr int I0 = 16 * 96, I1 = 32 * 16, I2 = 16 * 88;
    if (r < I0) { const int kt = r / 96, n0 = (r % 96) * 64; const int col = (n0 < 1024 || (n0 >= 3072 && n0 < 4096)) ? ret_qk_src_col(n0) : n0;
        cvt_tile(F, Src{F.ap->in[I_RWIN] + (size_t)j * 1024 * 6144 + col, 6144, 64}, kt * 64, W + WR_IN / 2 + (size_t)n0 * 1024, 1024, scr); return; } r -= I0;
    if (r < I1) { const int kt = r / 16, n0 = (r % 16) * 64;
        cvt_tile(F, Src{F.ap->in[I_RWOUT] + (size_t)j * 2048 * 1024 + n0, 1024, 64}, kt * 64, W + WR_OUT / 2 + (size_t)n0 * 2048, 2048, scr); return; } r -= I1;
    if (r < I2) { const int kt = r / 88, n0 = (r % 88) * 64; const int pn = n0 >> 8, p = n0 & 255, bj = p >> 7, rr = p & 127;
        const float* base = bj ? F.ap->in[I_FWU] : F.ap->in[I_FWG];
        cvt_tile(F, Src{base + (size_t)j * 1024 * 2816 + 128 * pn + rr, 2816, 64}, kt * 64, W + WR_GU / 2 + (size_t)n0 * 1024, 1024, scr); return; } r -= I2;
    { const int kt = r / 16, n0 = (r % 16) * 64;
        cvt_tile_f8(F, Src{F.ap->in[I_FWD] + (size_t)j * 2816 * 1024 + n0, 1024, 64}, kt * 64, (unsigned char*)(F.ws + WS_WRET) + WR_DN + (size_t)n0 * 2816, 2816, MOE_WDN_SCALE, scr); }
}
DI void cvt_gla_item(Frame& F, int j, int r, LAS unsigned* scr) {
    bf16* W = (bf16*)(F.ws + WS_WGLA);
    constexpr int I0 = 16 * 52, I1 = 16 * 16, I2 = 8 * 16 * 112;
    if (r < I0) { const int kt = r / 52, n0 = (r % 52) * 64; int nv = GLA_IN - n0; nv = nv < 0 ? 0 : (nv > 64 ? 64 : nv);
        cvt_tile(F, Src{F.ap->in[I_GWIN] + (size_t)j * 1024 * GLA_IN + n0, GLA_IN, nv}, kt * 64, W + WG_IN / 2 + (size_t)n0 * 1024, 1024, scr); return; } r -= I0;
    if (r < I1) { const int kt = r / 16, n0 = (r % 16) * 64;
        cvt_tile(F, Src{F.ap->in[I_GWOUT] + (size_t)j * 1024 * 1024 + n0, 1024, 64}, kt * 64, W + WG_OUT / 2 + (size_t)n0 * 1024, 1024, scr); return; } r -= I1;
    if (r < I2) { const int e = r / 1792, r2 = r % 1792, kt = r2 / 112, n0 = (r2 % 112) * 64; const int pn = n0 >> 8, p = n0 & 255, bj = p >> 7, rr = p & 127;
        const float* base = bj ? F.ap->in[I_MWU] : F.ap->in[I_MWG];
        cvt_tile_f8(F, Src{base + (size_t)(j * 8 + e) * 1024 * DFFE + 128 * pn + rr, DFFE, 64}, kt * 64, (unsigned char*)(F.ws + WS_WGLA) + WG_GU + ((size_t)e * 7168 + n0) * 1024, 1024, MOE_WGU_SCALE, scr); return; } r -= I2;
    { const int e = r / 896, r2 = r % 896, kt = r2 / 16, n0 = (r2 % 16) * 64;
        cvt_tile_f8(F, Src{F.ap->in[I_MWD] + (size_t)(j * 8 + e) * DFFE * 1024 + n0, 1024, 64}, kt * 64, (unsigned char*)(F.ws + WS_WGLA) + WG_DN + ((size_t)e * 1024 + n0) * DFFE, DFFE, MOE_WDN_SCALE, scr); }
}
DI void cvt_pull(Frame& F, int layer, int budget) {
    if (layer >= DEPTH) return;
    LAS unsigned* scr = (LAS unsigned*)(F.lds + F.wave * 16384);
    unsigned* q = (unsigned*)(F.ws + WS_CTL) + CW_CVTQ + 64 * layer;
    const int n = (layer & 1) ? CVT_GLA_ITEMS : CVT_RET_ITEMS, j = layer >> 1;
    for (int k = 0; budget < 0 || k < budget; k += 2) {
        int t = 0; if (F.lane == 0) t = (int)__hip_atomic_fetch_add(q, 2u, __ATOMIC_RELAXED, __HIP_MEMORY_SCOPE_AGENT);
        t = __builtin_amdgcn_readfirstlane(t);
        if (t >= n) break;
        if (layer & 1) { cvt_gla_item(F, j, t, scr); if (t + 1 < n) cvt_gla_item(F, j, t + 1, scr); }
        else           { cvt_ret_item(F, j, t, scr); if (t + 1 < n) cvt_ret_item(F, j, t + 1, scr); }
    }
}
DI void cvt_layer_static(Frame& F, int layer) {
    LAS unsigned* scr = (LAS unsigned*)(F.lds + F.wave * 16384); const int j = layer >> 1;
    if (layer & 1) { for (int it = F.gw; it < CVT_GLA_ITEMS; it += F.NGW) cvt_gla_item(F, j, it, scr); }
    else           { for (int it = F.gw; it < CVT_RET_ITEMS; it += F.NGW) cvt_ret_item(F, j, it, scr); }
}
DI void cvt_part(Frame& F, int layer, int first, int end, int idx, int per) {
    if (layer >= DEPTH) return;
    LAS unsigned* scr = (LAS unsigned*)(F.lds + F.wave * 16384); const int j = layer >> 1;
    for (int k = 0; k < per; ++k) { const int it = first + idx * per + k; if (it >= end) break;
        if (layer & 1) cvt_gla_item(F, j, it, scr); else cvt_ret_item(F, j, it, scr); }
}
DI void cvt_fill_after_gemm(Frame& F, int layer, int nwg, int budget) {
    const int c = (int)blockIdx.x, G = F.G; const int nu = (c < nwg) ? (nwg - 1 - c) / G + 1 : 0, maxr = (nwg + G - 1) / G;
    if (nu < maxr && F.wave < CVT_FILL_WAVES) cvt_pull(F, layer + 1, budget);
}

DI void ph_prologue(Frame& F) {
    LAS float* sc = (LAS float*)F.lds;
    LAS float* part = sc + 9 * 1024;
    float* mods = (float*)(F.ws + WS_MODS);
    for (int i = F.tid; i < 9 * 1024; i += 512) { const float c = (i < 8192) ? F.ap->in[I_C][i] : F.ap->in[I_CCTX][i - 8192]; sc[i] = silu(c); }
    __syncthreads();
    for (int item = blockIdx.x; item < 192; item += F.G) {
        const int li = item / 48, cg = item % 48, col = F.tid & 127, kq = F.tid >> 7;
        float acc[9];
#pragma unroll
        for (int s = 0; s < 9; ++s) acc[s] = 0.f;
        const float* w = F.ap->in[I_ADAW] + ((size_t)li * 1024 + kq * 256) * 6144 + cg * 128 + col;
        for (int k0 = 0; k0 < 256; k0 += 16) {
            float wq[16];
#pragma unroll
            for (int u = 0; u < 16; ++u) wq[u] = w[(size_t)(k0 + u) * 6144];
#pragma unroll
            for (int kk = 0; kk < 16; kk += 8) { const int k = k0 + kk; const float wv[8] = {wq[kk], wq[kk + 1], wq[kk + 2], wq[kk + 3], wq[kk + 4], wq[kk + 5], wq[kk + 6], wq[kk + 7]};
#pragma unroll
                for (int s = 0; s < 9; ++s) { const f32x4 c0 = *(const LAS f32x4*)(sc + s * 1024 + kq * 256 + k), c1 = *(const LAS f32x4*)(sc + s * 1024 + kq * 256 + k + 4);
                    acc[s] += (c0[0] * wv[0] + c0[1] * wv[1]) + (c0[2] * wv[2] + c0[3] * wv[3]) + (c1[0] * wv[4] + c1[1] * wv[5]) + (c1[2] * wv[6] + c1[3] * wv[7]); } }
        }
#pragma unroll
        for (int s = 0; s < 9; ++s) part[(kq * 9 + s) * 128 + col] = acc[s];
        __syncthreads();
        for (int o = F.tid; o < 9 * 128; o += 512) { const int s = o >> 7, cc = o & 127;
            const float v = (part[(0 * 9 + s) * 128 + cc] + part[(1 * 9 + s) * 128 + cc]) + (part[(2 * 9 + s) * 128 + cc] + part[(3 * 9 + s) * 128 + cc]) + F.ap->in[I_ADAB][li * 6144 + cg * 128 + cc];
            mods[(size_t)(li * 9 + s) * 6144 + cg * 128 + cc] = v; }
        __syncthreads();
    }
    float* ropec = (float*)(F.ws + WS_ROPE); float* ropes = ropec + 4096;
    for (int i = blockIdx.x * 512 + F.tid; i < 4096; i += F.G * 512) { const int pos = i >> 6, idx = i & 63;
        const float freq = exp2f(-(float)idx * (13.287712379549449f / 64.0f)); float sn, cs; sincosf((float)pos * freq, &sn, &cs); ropec[i] = cs; ropes[i] = sn; }
    __syncthreads();
}

template <int MODE, bool PF = false> DI void ph_norm(Frame& F,     int layer, int which, bool moe_in, int row_lo, const float* rd_ctx, const float* rd_lat, int nslab, const float* slab_gate, int cvt_layer = -1, int cvt_per_row = 0, int cvt_end = 1 << 30, int cvt_first = 0) {
    const float* mods = (const float*)(F.ws + WS_MODS);
    bf16* TOK = (bf16*)(F.ws + WS_TOK); bf16* HA = (bf16*)(F.ws + WS_HA); const bf16* YB = (const bf16*)(F.ws + WS_YB);
    const float* ng = (MODE == 2) ? F.ap->in[I_FING] : ((which ? F.ap->in[I_NFFN] : F.ap->in[I_NMIX]) + layer * 1024);
    const int lane = F.lane; const int j2 = layer >> 1;
    LAS int* lcnt = (LAS int*)F.lds; LAS int* lbase = lcnt + 8; LAS int* list = lcnt + 16;
    int nl = 0;
    LAS float* wl = (LAS float*)(F.lds + 65536);
    if (MODE == 1) { if (F.tid < 8) lcnt[F.tid] = 0;
        const float* wr = F.ap->in[I_MWR] + (size_t)j2 * 1024 * 8;
        f32x4 t4[4];
#pragma unroll
        for (int k = 0; k < 4; ++k) t4[k] = *(const f32x4*)(wr + (size_t)(F.tid + 512 * k) * 4);
#pragma unroll
        for (int k = 0; k < 4; ++k) { const int i = F.tid + 512 * k, r = i >> 1; *(LAS f32x4*)(wl + r * 8 + (r >> 2) * 4 + (i & 1) * 4) = t4[k]; }
        __syncthreads(); }
    f32x4 gv[4];
#pragma unroll
    for (int j = 0; j < 4; ++j) gv[j] = *(const f32x4*)(ng + 4 * lane + 256 * j);
    LAS unsigned* cvt_scr = (LAS unsigned*)(F.lds + 32768 + F.wave * 12288);
    int cvt_n = cvt_layer < 0 ? 0 : ((cvt_layer & 1) ? CVT_GLA_ITEMS : CVT_RET_ITEMS); cvt_n = cvt_n < cvt_end ? cvt_n : cvt_end; int cvt_it = cvt_first + F.gw;
    f32x4 xn[4]; u32x2 xr[4];
    f32x4 shn[4], scn[4];
#pragma unroll
    for (int j = 0; j < 4; ++j) { xn[j] = (f32x4){0.f, 0.f, 0.f, 0.f}; xr[j] = (u32x2){0u, 0u}; shn[j] = xn[j]; scn[j] = xn[j]; }
#define NORM_LOAD(rw) do { const float* rf_ = ((rw) < NCTX ? rd_ctx : rd_lat); \
        if (PF && MODE != 2) { const int s_ = (rw) < NCTX ? 8 : (((rw) - NCTX) >> 11); const float* mp_ = mods + (size_t)(layer * 9 + s_) * 6144 + (which ? 3072 : 0) + 4 * lane; \
            _Pragma("unroll") for (int j = 0; j < 4; ++j) { shn[j] = *(const f32x4*)(mp_ + 256 * j); scn[j] = *(const f32x4*)(mp_ + 1024 + 256 * j); } } \
        if (rf_) { const float* rr_ = rf_ + (size_t)(rw) * 1024 + 4 * lane; _Pragma("unroll") for (int j = 0; j < 4; ++j) xn[j] = *(const f32x4*)(rr_ + 256 * j); } \
        else { const bf16* rb_ = TOK + (size_t)(rw) * 1024 + 4 * lane; _Pragma("unroll") for (int j = 0; j < 4; ++j) xr[j] = *(const u32x2*)(rb_ + 256 * j); } } while (0)
    { const int row = row_lo + F.gw; if (row < NTOK) { NORM_LOAD(row);
        if (MODE == 2) { float* o = F.out + (size_t)(row - NCTX) * 1024 + 4 * lane;
#pragma unroll
            for (int j = 0; j < 4; ++j) *(f32x4*)(o + 256 * j) = (f32x4){0.f, 0.f, 0.f, 0.f}; }
        else if (MODE == 1) {
#pragma unroll
            for (int j = 0; j < 4; ++j) *(unsigned*)((unsigned char*)HA + (size_t)row * 1024 + 4 * lane + 256 * j) = 0u; }
        else {
#pragma unroll
            for (int j = 0; j < 4; ++j) *(u32x2*)(HA + (size_t)row * 1024 + 4 * lane + 256 * j) = (u32x2){0u, 0u}; } } }
    for (int row = row_lo + F.gw; row < NTOK; row += F.NGW) {
        const int s = row < NCTX ? 8 : ((row - NCTX) >> 11);
        bf16* tr = TOK + (size_t)row * 1024 + 4 * lane;
        f32x4 x[4];
        if ((row < NCTX ? rd_ctx : rd_lat) != nullptr) {
#pragma unroll
            for (int j = 0; j < 4; ++j) x[j] = xn[j];
        } else {
#pragma unroll
            for (int j = 0; j < 4; ++j) x[j] = (f32x4){bf_lo(xr[j].x), bf_hi(xr[j].x), bf_lo(xr[j].y), bf_hi(xr[j].y)};
        }
        f32x4 shv[4], scv[4];
        if (PF) {
#pragma unroll
            for (int j = 0; j < 4; ++j) { shv[j] = shn[j]; scv[j] = scn[j]; } }
        { const int rown = row + F.NGW; if (rown < NTOK) NORM_LOAD(rown); }
#undef NORM_LOAD
        if (MODE == 0) { for (int t = 0; t < cvt_per_row && cvt_it < cvt_n; ++t, cvt_it += F.NGW) { if (cvt_layer & 1) cvt_gla_item(F, cvt_layer >> 1, cvt_it, cvt_scr); else cvt_ret_item(F, cvt_layer >> 1, cvt_it, cvt_scr); } }

        if (!PF && MODE != 2) { const float* mp = mods + (size_t)(layer * 9 + s) * 6144 + (which ? 3072 : 0) + 4 * lane;
#pragma unroll
            for (int j = 0; j < 4; ++j) { shv[j] = *(const f32x4*)(mp + 256 * j); scv[j] = *(const f32x4*)(mp + 1024 + 256 * j); } }
        if (row < NCTX && nslab > 0) {
            const bf16* ps = (const bf16*)(F.ws + WS_PS) + (size_t)row * 1024 + 4 * lane;
            u32x2 pw[8][4]; f32x4 sg[4];
#pragma unroll
            for (int q = 0; q < 8; ++q)
#pragma unroll
                for (int j = 0; j < 4; ++j) { pw[q][j] = (u32x2){0u, 0u}; if (q < nslab) pw[q][j] = *(const u32x2*)(ps + (size_t)q * NCTX * 1024 + 256 * j); }
#pragma unroll
            for (int j = 0; j < 4; ++j) sg[j] = *(const f32x4*)(slab_gate + 4 * lane + 256 * j);
            u32x2 tw[4];
#pragma unroll
            for (int j = 0; j < 4; ++j) { f32x4 a = {0.f, 0.f, 0.f, 0.f};
#pragma unroll
                for (int q = 0; q < 8; ++q) a = a + (f32x4){bf_lo(pw[q][j].x), bf_hi(pw[q][j].x), bf_lo(pw[q][j].y), bf_hi(pw[q][j].y)};
                x[j] = x[j] + sg[j] * a; tw[j].x = pk2(x[j][0], x[j][1]); tw[j].y = pk2(x[j][2], x[j][3]); }
#pragma unroll
            for (int j = 0; j < 4; ++j) *(u32x2*)(tr + 256 * j) = tw[j];
        }
        if (moe_in) {
            const float* g2 = mods + (size_t)((layer - 1) * 9 + s) * 6144 + 5120 + 4 * lane; const bf16* y0 = YB + (size_t)row * (2048 * MOE_KSPLIT) + 4 * lane;
            u32x2 yw[2 * MOE_KSPLIT][4]; f32x4 g2v[4]; u32x2 tw[4];
#pragma unroll
            for (int q = 0; q < 2 * MOE_KSPLIT; ++q)
#pragma unroll
                for (int j = 0; j < 4; ++j) yw[q][j] = *(const u32x2*)(y0 + 1024 * q + 256 * j);
#pragma unroll
            for (int j = 0; j < 4; ++j) g2v[j] = *(const f32x4*)(g2 + 256 * j);
#pragma unroll
            for (int j = 0; j < 4; ++j) { f32x4 ya = {0.f, 0.f, 0.f, 0.f};
#pragma unroll
                for (int q = 0; q < 2 * MOE_KSPLIT; ++q) ya = ya + (f32x4){bf_lo(yw[q][j].x), bf_hi(yw[q][j].x), bf_lo(yw[q][j].y), bf_hi(yw[q][j].y)};
                x[j] = x[j] + g2v[j] * ya; tw[j].x = pk2(x[j][0], x[j][1]); tw[j].y = pk2(x[j][2], x[j][3]); }
            if (MODE != 2) {
#pragma unroll
                for (int j = 0; j < 4; ++j) *(u32x2*)(tr + 256 * j) = tw[j]; }
        }
        float ss = 0.f;
#pragma unroll
        for (int j = 0; j < 4; ++j) ss += (x[j][0] * x[j][0] + x[j][1] * x[j][1]) + (x[j][2] * x[j][2] + x[j][3] * x[j][3]);
        const float rstd = __builtin_amdgcn_rsqf(wave_sum(ss, lane) * (1.0f / 1024.0f) + EPS);
        if (MODE == 2) {
            float* o = F.out + (size_t)(row - NCTX) * 1024 + 4 * lane;
#pragma unroll
            for (int j = 0; j < 4; ++j) *(f32x4*)(o + 256 * j) = x[j] * rstd * gv[j];
        } else {
            f32x4 h[4];
#pragma unroll
            for (int j = 0; j < 4; ++j) { h[j] = x[j] * rstd * gv[j] * (scv[j] + 1.0f) + shv[j]; }
#pragma unroll
            for (int j = 0; j < 4; ++j) {
                if (MODE == 1) *(unsigned*)((unsigned char*)HA + (size_t)row * 1024 + 4 * lane + 256 * j) = pg8::pack4_fp8(h[j][0], h[j][1], h[j][2], h[j][3]);
                else { u32x2 w; w.x = pk2(h[j][0], h[j][1]); w.y = pk2(h[j][2], h[j][3]); *(u32x2*)(HA + (size_t)row * 1024 + 4 * lane + 256 * j) = w; } }
            if (MODE == 1) {
                float l[8];
#pragma unroll
                for (int e = 0; e < 8; ++e) l[e] = 0.f;
#pragma unroll
                for (int j = 0; j < 4; ++j)
#pragma unroll
                    for (int q = 0; q < 4; ++q) { const LAS float* wp = wl + (4 * lane + 256 * j + q) * 8 + (lane + 64 * j) * 4; const f32x4 w0 = *(const LAS f32x4*)wp, w1 = *(const LAS f32x4*)(wp + 4); const float hv = h[j][q];
                        l[0] += hv * w0[0]; l[1] += hv * w0[1]; l[2] += hv * w0[2]; l[3] += hv * w0[3]; l[4] += hv * w1[0]; l[5] += hv * w1[1]; l[6] += hv * w1[2]; l[7] += hv * w1[3]; }
#pragma unroll
                for (int e = 0; e < 8; ++e) l[e] = wave_sum(l[e], lane);
                int e0 = 0; float v0 = l[0];
#pragma unroll
                for (int e = 1; e < 8; ++e) if (l[e] > v0) { v0 = l[e]; e0 = e; }
                int e1 = -1; float v1 = -3.0e38f;
#pragma unroll
                for (int e = 0; e < 8; ++e) if (e != e0 && l[e] > v1) { v1 = l[e]; e1 = e; }
                const float w0 = 1.0f / (1.0f + __expf(v1 - v0));
                if (lane == 0) { const int p0 = __hip_atomic_fetch_add(lcnt + e0, 1, __ATOMIC_RELAXED, __HIP_MEMORY_SCOPE_WORKGROUP), p1 = __hip_atomic_fetch_add(lcnt + e1, 1, __ATOMIC_RELAXED, __HIP_MEMORY_SCOPE_WORKGROUP);
                    LAS int* q = list + (F.wave * 32 + nl) * 4; q[0] = row; q[1] = e0 | (e1 << 8); q[2] = p0 | (p1 << 16); q[3] = (int)__float_as_uint(w0); }
                ++nl;
            }
        }
    }
    if (MODE == 0) { for (; cvt_it < cvt_n; cvt_it += F.NGW) { if (cvt_layer & 1) cvt_gla_item(F, cvt_layer >> 1, cvt_it, cvt_scr); else cvt_ret_item(F, cvt_layer >> 1, cvt_it, cvt_scr); } }
    if (MODE == 1) {
        unsigned* gc = (unsigned*)(F.ws + WS_CTL) + CW_GCNT + 64 * j2;
        __syncthreads();
        if (F.tid < 8) lbase[F.tid] = (int)__hip_atomic_fetch_add(gc + F.tid, (unsigned)lcnt[F.tid], __ATOMIC_RELAXED, __HIP_MEMORY_SCOPE_AGENT);
        __syncthreads();
        if (lane < nl) { const LAS int* q = list + (F.wave * 32 + lane) * 4; const int row = q[0], ee = q[1], pp = q[2]; const float w0 = __uint_as_float((unsigned)q[3]);
            const int R0 = (ee & 255) * NTOK + lbase[ee & 255] + (pp & 0xffff), R1 = (ee >> 8) * NTOK + lbase[ee >> 8] + (pp >> 16);
            int* rinfo = (int*)(F.ws + WS_RINFO); float* rw = (float*)(F.ws + WS_RW);
            rinfo[R0] = row * 2; rw[R0] = w0; rinfo[R1] = row * 2 + 1; rw[R1] = 1.0f - w0; }
    }
}

DI void moe_counts(Frame& F, int j2, int (&cnt)[8]) {
    unsigned* gc = (unsigned*)(F.ws + WS_CTL) + CW_GCNT + 64 * j2;
#pragma unroll
    for (int e = 0; e < 8; ++e) cnt[e] = __builtin_amdgcn_readfirstlane((int)__hip_atomic_load(gc + e, __ATOMIC_RELAXED, __HIP_MEMORY_SCOPE_AGENT));
}
DI void ph_scatter(Frame& F, int j2, int row_lo) {
    LAS int* offs = (LAS int*)F.lds;
    int cnt[8]; moe_counts(F, j2, cnt);
    if (F.tid == 0) { int o = 0;
#pragma unroll
        for (int e = 0; e < 8; ++e) { offs[e] = o; offs[16 + e] = cnt[e]; o += (cnt[e] + 255) & ~255; }
        offs[8] = o; }
    __syncthreads();
    const int lane = F.lane;
    const bf16* HA = (const bf16*)(F.ws + WS_HA); unsigned char* AG8 = (unsigned char*)(F.ws + WS_AG);
    int* rinfo = (int*)(F.ws + WS_RINFO); float* rw = (float*)(F.ws + WS_RW);
    for (int row = row_lo + F.gw; row < NTOK; row += F.NGW) {
        const int ee = ((const int*)(F.ws + WS_TIE))[row], p0 = ((const int*)(F.ws + WS_TIP0))[row], p1 = ((const int*)(F.ws + WS_TIP1))[row];
        const float w0 = ((const float*)(F.ws + WS_TIW))[row];
        const u32x4* src = (const u32x4*)(HA + (size_t)row * 1024); const u32x4 a = src[2 * lane], b = src[2 * lane + 1];
        const int R0 = offs[ee & 255] + p0, R1 = offs[ee >> 8] + p1;
        u32x4 o8;
        o8.x = pg8::pack4_fp8(bf_lo(a.x), bf_hi(a.x), bf_lo(a.y), bf_hi(a.y)); o8.y = pg8::pack4_fp8(bf_lo(a.z), bf_hi(a.z), bf_lo(a.w), bf_hi(a.w));
        o8.z = pg8::pack4_fp8(bf_lo(b.x), bf_hi(b.x), bf_lo(b.y), bf_hi(b.y)); o8.w = pg8::pack4_fp8(bf_lo(b.z), bf_hi(b.z), bf_lo(b.w), bf_hi(b.w));
        ((u32x4*)(AG8 + (size_t)R0 * 1024))[lane] = o8; ((u32x4*)(AG8 + (size_t)R1 * 1024))[lane] = o8;
        if (lane == 0) { rinfo[R0] = row * 2; rw[R0] = w0; rinfo[R1] = row * 2 + 1; rw[R1] = 1.0f - w0; }
    }
    if (blockIdx.x < 8) { const int e = blockIdx.x; const int lo = offs[e] + offs[16 + e], hi = offs[e + 1];
        unsigned zz; asm volatile("v_mov_b32 %0, 0" : "=v"(zz));
        const u32x4 z = {zz, zz, zz, zz};
        for (int R = lo + F.wave; R < hi; R += NWAVES) { u32x4* d = (u32x4*)(AG8 + (size_t)R * 1024); d[lane] = z; if (lane == 0) rinfo[R] = -1; } }
}
DI void moe_order(Frame& F, int j2, int nN, int nsplit, int ntf, pg8::MoeOrder& S) {
    int cnt[8]; moe_counts(F, j2, cnt);
    int o = 0;
#pragma unroll
    for (int e = 0; e < 8; ++e) { S.poff[e] = o; S.cnt[e] = cnt[e]; o += (cnt[e] + 255) >> 8; }
    S.cap = NTOK;
    S.poff[8] = o; S.nM = o; S.nN = nN; S.nsplit = nsplit; S.ntf = ntf; S.nwg = o * nN * nsplit; S.G = F.G; S.c = (int)blockIdx.x;
}

template <bool GLA> DI void ph_finish(Frame& F, int j2, int row_lo) {
    const int lane = F.lane;
    const bf16* P = (const bf16*)(F.ws + WS_P); const bf16* OF = (const bf16*)(F.ws + WS_OF); const bf16* OB = (const bf16*)(F.ws + WS_OB); bf16* A2 = (bf16*)(F.ws + WS_A2);
    const int nit = (NTOK - row_lo) * 4; const int NGW = F.NGW;
    if (!GLA) {
        u32x4 an[2], bn[2], gn[2];
#pragma unroll
        for (int u = 0; u < 2; ++u) { an[u] = (u32x4){0u, 0u, 0u, 0u}; bn[u] = an[u]; gn[u] = an[u]; }
#define FIN_LOAD(u, it_) do { const int i_ = (it_); if (i_ < nit) { const int row = row_lo + (i_ >> 2), h = i_ & 3; const size_t ob = (size_t)row * 2048 + h * 512 + lane * 8; \
            an[u] = *(const u32x4*)(OF + ob); bn[u] = *(const u32x4*)(OB + ob); gn[u] = *(const u32x4*)(P + (size_t)row * RET_IN + 1024 + h * 512 + lane * 8); } } while (0)
        FIN_LOAD(0, F.gw); FIN_LOAD(1, F.gw + NGW);
        const int hw = F.gw & 3;
        const float* gw = F.ap->in[I_RGNW] + j2 * 2048 + hw * 512 + lane * 8; const float* gb = F.ap->in[I_RGNB] + j2 * 2048 + hw * 512 + lane * 8;
        const f32x4 w0 = *(const f32x4*)gw, w1 = *(const f32x4*)(gw + 4), b0 = *(const f32x4*)gb, b1 = *(const f32x4*)(gb + 4);
        for (int it = F.gw; it < nit; it += 2 * NGW) {
            u32x4 av[2], bv[2], gvv[2];
#pragma unroll
            for (int u = 0; u < 2; ++u) { av[u] = an[u]; bv[u] = bn[u]; gvv[u] = gn[u]; }
            FIN_LOAD(0, it + 2 * NGW); FIN_LOAD(1, it + 3 * NGW);
#pragma unroll
            for (int u = 0; u < 2; ++u) { const int itu = it + u * NGW;
                if (itu < nit) {
                    const int row = row_lo + (itu >> 2), h = itu & 3;
                    const size_t ob = (size_t)row * 2048 + h * 512 + lane * 8;
                    const u32x4 a = av[u], b = bv[u], g = gvv[u];
                    float o[8], gg[8];
#pragma unroll
                    for (int q = 0; q < 4; ++q) { o[2 * q] = bf_lo(a[q]) + bf_lo(b[q]); o[2 * q + 1] = bf_hi(a[q]) + bf_hi(b[q]); gg[2 * q] = bf_lo(g[q]); gg[2 * q + 1] = bf_hi(g[q]); }
                    float s = 0.f;
#pragma unroll
                    for (int q = 0; q < 8; ++q) s += o[q];
                    const float mean = wave_sum(s, lane) * (1.0f / 512.0f); float s2 = 0.f;
#pragma unroll
                    for (int q = 0; q < 8; ++q) { o[q] -= mean; s2 += o[q] * o[q]; }
                    const float rstd = __builtin_amdgcn_rsqf(wave_sum(s2, lane) * (1.0f / 512.0f) + EPS);
                    float y[8];
#pragma unroll
                    for (int q = 0; q < 8; ++q) { const float wv = q < 4 ? w0[q & 3] : w1[q & 3], bvv = q < 4 ? b0[q & 3] : b1[q & 3]; y[q] = (o[q] * rstd * wv + bvv) * silu(gg[q]); }
                    u32x4 w; w.x = pk2(y[0], y[1]); w.y = pk2(y[2], y[3]); w.z = pk2(y[4], y[5]); w.w = pk2(y[6], y[7]);
                    *(u32x4*)(A2 + ob) = w;
                }
            }
        }
#undef FIN_LOAD
    } else {
        u32x2 an[2], bn[2], gn[2];
#pragma unroll
        for (int u = 0; u < 2; ++u) { an[u] = (u32x2){0u, 0u}; bn[u] = an[u]; gn[u] = an[u]; }
#define FIN_LOAD(u, it_) do { const int i_ = (it_); if (i_ < nit) { const int row = row_lo + (i_ >> 2), h = i_ & 3; const size_t ob = (size_t)row * 1024 + h * 256 + lane * 4; \
            an[u] = *(const u32x2*)(OF + ob); bn[u] = *(const u32x2*)(OB + ob); gn[u] = *(const u32x2*)(P + (size_t)row * GLA_INP + 512 + h * 256 + lane * 4); } } while (0)
        FIN_LOAD(0, F.gw); FIN_LOAD(1, F.gw + NGW);
        const f32x4 w0 = *(const f32x4*)(F.ap->in[I_GNG] + j2 * 1024 + (F.gw & 3) * 256 + lane * 4);
        for (int it = F.gw; it < nit; it += 2 * NGW) {
            u32x2 av[2], bv[2], gvv[2];
#pragma unroll
            for (int u = 0; u < 2; ++u) { av[u] = an[u]; bv[u] = bn[u]; gvv[u] = gn[u]; }
            FIN_LOAD(0, it + 2 * NGW); FIN_LOAD(1, it + 3 * NGW);
#pragma unroll
            for (int u = 0; u < 2; ++u) { const int itu = it + u * NGW;
                if (itu < nit) {
                    const int row = row_lo + (itu >> 2), h = itu & 3;
                    const size_t ob = (size_t)row * 1024 + h * 256 + lane * 4;
                    const u32x2 a = av[u], b = bv[u], g = gvv[u];
                    float o[4], gg[4];
#pragma unroll
                    for (int q = 0; q < 2; ++q) { o[2 * q] = bf_lo(a[q]) + bf_lo(b[q]); o[2 * q + 1] = bf_hi(a[q]) + bf_hi(b[q]); gg[2 * q] = bf_lo(g[q]); gg[2 * q + 1] = bf_hi(g[q]); }
                    const float s2 = (o[0] * o[0] + o[1] * o[1]) + (o[2] * o[2] + o[3] * o[3]);
                    const float rstd = __builtin_amdgcn_rsqf(wave_sum(s2, lane) * (1.0f / 256.0f) + EPS);
                    float y[4];
#pragma unroll
                    for (int q = 0; q < 4; ++q) y[q] = o[q] * rstd * w0[q] * silu(gg[q]);
                    u32x2 w; w.x = pk2(y[0], y[1]); w.y = pk2(y[2], y[3]);
                    *(u32x2*)(A2 + ob) = w;
                }
            }
        }
#undef FIN_LOAD
    }
}

template <bool GLA> DI void ph_scan_naive(Frame& F, int j2) {
    constexpr int TB = 16, DK = GLA ? 128 : 256, VS = GLA ? 64 : 128, NDQ = 512 / VS, DPT = DK / NDQ;
    constexpr int PLD = GLA ? GLA_INP : RET_IN, QOFF = 0, KOFF = GLA ? 1536 : 3072, VOFF = GLA ? 2048 : 4096, DV = GLA ? 256 : 512, OLD = GLA ? 1024 : 2048;
    LAS float* qs = (LAS float*)F.lds;
    LAS float* ks = qs + TB * DK;
    LAS float* al = ks + TB * DK;
    LAS float* vs = al + TB * DK;
    LAS float* asv = vs + TB * VS;
    LAS float* part = asv + TB * 16;
    const bf16* P = (const bf16*)(F.ws + WS_P); const float* AF = (const float*)(F.ws + WS_AF);
    const int tid = F.tid, col = tid & (VS - 1), dq = tid / VS;
    for (int item = blockIdx.x; item < 256; item += F.G) {
        const int vsl = item & 3, dir = (item >> 2) & 1, h = (item >> 3) & 3, b = item >> 5;
        bf16* O = (bf16*)(F.ws + (dir ? WS_OB : WS_OF));
        float gamma = 1.f;
        if (!GLA) gamma = expf(-expf(F.ap->in[I_RDEC][j2 * 8 + dir * 4 + h]));
        const float* wup = F.ap->in[I_GWUP] + (size_t)((j2 * 2 + dir) * 16) * 512 + h * 128; const float* bg = F.ap->in[I_GBG] + (j2 * 2 + dir) * 512 + h * 128;
        float s[DPT];
#pragma unroll
        for (int d = 0; d < DPT; ++d) s[d] = 0.f;
        for (int seg = 0; seg < 2; ++seg) {
            const int L = seg ? SEQ : CTXL, rowbase = seg ? NCTX + b * SEQ : b * CTXL;
            for (int blk = 0; blk < L / TB; ++blk) {
                __syncthreads();
                {
                    constexpr int TPR = DK / 8;
                    const int which = tid / (TB * TPR);
                    if (GLA) { const int tt = (tid % (TB * TPR)) / TPR, d0 = (tid % TPR) * 8; const int pi = blk * TB + tt, t = dir ? L - 1 - pi : pi;
                        const u32x4 w = *(const u32x4*)(P + (size_t)(rowbase + t) * PLD + (which ? KOFF : QOFF) + h * DK + d0); LAS float* dst = (which ? ks : qs) + tt * DK + d0;
#pragma unroll
                        for (int q = 0; q < 4; ++q) { dst[2 * q] = bf_lo(w[q]); dst[2 * q + 1] = bf_hi(w[q]); }
                    } else { const int tt = tid / TPR, d0 = (tid % TPR) * 8; const int pi = blk * TB + tt, t = dir ? L - 1 - pi : pi;
                        const bf16* rp = P + (size_t)(rowbase + t) * PLD + h * DK + d0; const u32x4 wq = *(const u32x4*)(rp + QOFF), wk = *(const u32x4*)(rp + KOFF);
#pragma unroll
                        for (int q = 0; q < 4; ++q) { qs[tt * DK + d0 + 2 * q] = bf_lo(wq[q]); qs[tt * DK + d0 + 2 * q + 1] = bf_hi(wq[q]); ks[tt * DK + d0 + 2 * q] = bf_lo(wk[q]); ks[tt * DK + d0 + 2 * q + 1] = bf_hi(wk[q]); }
                    }
                    if (tid < TB * VS / 8) { const int tt = tid / (VS / 8), c0 = (tid % (VS / 8)) * 8; const int pi = blk * TB + tt, t = dir ? L - 1 - pi : pi;
                        const u32x4 w = *(const u32x4*)(P + (size_t)(rowbase + t) * PLD + VOFF + h * DV + vsl * VS + c0);
#pragma unroll
                        for (int q = 0; q < 4; ++q) { vs[tt * VS + c0 + 2 * q] = bf_lo(w[q]); vs[tt * VS + c0 + 2 * q + 1] = bf_hi(w[q]); } }
                    if (GLA && tid >= 256) { const int u = tid - 256, tt = u >> 4, r = u & 15; const int pi = blk * TB + tt, t = dir ? L - 1 - pi : pi; asv[tt * 16 + r] = AF[(size_t)(rowbase + t) * 32 + dir * 16 + r]; }
                }
                __syncthreads();
                if (GLA) {
                    const int tt = tid >> 5, d0 = (tid & 31) * 4;
                    f32x4 z = *(const f32x4*)(bg + d0);
#pragma unroll
                    for (int r = 0; r < 16; ++r) z = z + *(const f32x4*)(wup + (size_t)r * 512 + d0) * asv[tt * 16 + r];
#pragma unroll
                    for (int q = 0; q < 4; ++q) { const float zz = z[q]; const float ls = fminf(zz, 0.f) - log1pf(expf(-fabsf(zz))); al[tt * DK + d0 + q] = expf(ls * (1.0f / 16.0f)); }
                    __syncthreads();
                }
                for (int tt = 0; tt < TB; ++tt) {
                    const float vv = vs[tt * VS + col]; float po = 0.f;
#pragma unroll
                    for (int d4 = 0; d4 < DPT / 4; ++d4) {
                        const f32x4 kk = *(const LAS f32x4*)(ks + tt * DK + dq * DPT + 4 * d4), qq = *(const LAS f32x4*)(qs + tt * DK + dq * DPT + 4 * d4);
                        f32x4 aa = {gamma, gamma, gamma, gamma}; if (GLA) aa = *(const LAS f32x4*)(al + tt * DK + dq * DPT + 4 * d4);
#pragma unroll
                        for (int e = 0; e < 4; ++e) { s[4 * d4 + e] = aa[e] * s[4 * d4 + e] + kk[e] * vv; po += qq[e] * s[4 * d4 + e]; }
                    }
                    part[(tt * NDQ + dq) * VS + col] = po;
                }
                __syncthreads();
                {
                    constexpr int TPT = VS / 4;
                    if (tid < TB * TPT) { const int tt = tid / TPT, c4 = (tid % TPT) * 4; const int pi = blk * TB + tt, t = dir ? L - 1 - pi : pi;
                        f32x4 o = {0.f, 0.f, 0.f, 0.f};
#pragma unroll
                        for (int g = 0; g < NDQ; ++g) o = o + *(const LAS f32x4*)(part + (tt * NDQ + g) * VS + c4);
                        u32x2 w; w.x = pk2(o[0], o[1]); w.y = pk2(o[2], o[3]);
                        *(u32x2*)(O + (size_t)(rowbase + t) * OLD + h * DV + vsl * VS + c4) = w; }
                }
            }
        }
        __syncthreads();
    }
}

typedef short s16x4 __attribute__((ext_vector_type(4)));
typedef short s16x8 __attribute__((ext_vector_type(8)));
typedef __bf16 bf16x2_t __attribute__((ext_vector_type(2)));
DI unsigned pkc(float lo, float hi) { f32x2 v = {lo, hi}; return __builtin_bit_cast(unsigned, __builtin_convertvector(v, bf16x2_t)); }
DI s16x8 cat8(s16x4 lo, s16x4 hi) { return __builtin_shufflevector(lo, hi, 0, 1, 2, 3, 4, 5, 6, 7); }
DI s16x4 tr_rd(LAS unsigned char* p) { return __builtin_amdgcn_ds_read_tr16_b64_v4i16((LAS s16x4*)p); }
#define SCAN_BAR() do { asm volatile("s_waitcnt lgkmcnt(0)" ::: "memory"); __builtin_amdgcn_s_barrier(); asm volatile("" ::: "memory"); } while (0)
#define MFMA16(a, b, c) __builtin_amdgcn_mfma_f32_16x16x32_bf16((a), (b), (c), 0, 0, 0)

struct ScanTagT { static constexpr bool value = true; }; struct ScanTagF { static constexpr bool value = false; };
DI int scan_rowbase(int ci, int dir, int b) { const int nn = ci < 4 ? ci : ci - 4, ns = ci < 4 ? 4 : 32; const int cidx = dir ? ns - 1 - nn : nn; return (ci < 4 ? b * CTXL : NCTX + b * SEQ) + 64 * cidx; }
template <bool GLA> DI void ph_scan_mfma(Frame& F, int j2, int cvt_first = 0, int cvt_end = 0) {
    constexpr int DK = GLA ? 128 : 256, QLD = DK + 16, VLD = 136, PLDS = 80;
    constexpr int PLD = GLA ? GLA_INP : RET_IN, KOFF = GLA ? 1536 : 3072, VOFF = GLA ? 2048 : 4096, DV = GLA ? 256 : 512, OLD = GLA ? 1024 : 2048;
    constexpr int VS = GLA ? 64 : 128, NVW = VS / 16, NVP = VS / 64;
    constexpr int NITEMS = 256, NS = DK / 32, NDT = DK / 16, NQ = DK / 64;
    constexpr int KLD = DK + 16, KS_BYTES = 64 * KLD * 2 + 8 * 128;
#define SCAN_KROW(row) ((row) * (KLD * 2) + ((row) >> 3) * 128)
    constexpr int QS_OFF = 0, KS_OFF = 64 * QLD * 2, VS_OFF = KS_OFF + KS_BYTES, PM_OFF = VS_OFF + 64 * VLD * 2, QP_OFF = PM_OFF + 64 * PLDS * 2;
    static_assert(QP_OFF + 64 * QLD * 2 <= MISC_OFF, "scan LDS map");
    LAS unsigned char* L = F.lds;
    const int tid = F.tid, lane = F.lane, w = F.wave, g = lane >> 4, l15 = lane & 15, tq = l15 >> 2, tp = lane & 3;
    const bf16* P = (const bf16*)(F.ws + WS_P);
    for (int item0 = blockIdx.x; item0 < NITEMS; item0 += F.G) {
        int vsl, dir, h, b;
        {   const int x = item0 & 7, y = item0 >> 3; int grp;
            vsl = y & 3; grp = x + 8 * (y >> 2);
            dir = grp & 1; h = (grp >> 1) & 3; b = grp >> 3; }
        bf16* O = (bf16*)(F.ws + (dir ? WS_OB : WS_OF));
        float lgam = 0.f;
        if (!GLA) lgam = -expf(F.ap->in[I_RDEC][j2 * 8 + dir * 4 + h]);
        float qd[4], vsc[2];
#pragma unroll
        for (int nb = 0; nb < 4; ++nb) { const int t = 16 * nb + l15; qd[nb] = GLA ? 1.f : expf(lgam * (float)(dir ? 64 - t : t + 1)); }
#pragma unroll
        for (int i = 0; i < 2; ++i) { const int row = (tid + 512 * i) / (VS / 8); vsc[i] = GLA ? 1.f : expf(-lgam * (float)(dir ? 64 - row : row + 1)); }
        const float gC = GLA ? 1.f : expf(lgam * 64.f);
        const bf16* QG = GLA ? (const bf16*)(F.ws + WS_QT) + (size_t)dir * NTOK * 512 : P; const bf16* KG = GLA ? (const bf16*)(F.ws + WS_QT) + (size_t)(2 + dir) * NTOK * 512 : P + KOFF;
        constexpr int QGLD = GLA ? 512 : PLD;
        const float* EBG = (const float*)(F.ws + WS_EB);
        f32x4 S[NDT];
#pragma unroll
        for (int i = 0; i < NDT; ++i) S[i] = (f32x4){0.f, 0.f, 0.f, 0.f};
        u32x4 qreg[NQ], kreg[NQ], vreg[2];
#define SCAN_LOAD(ci) do { const int rb_ = scan_rowbase(ci, dir, b); \
        _Pragma("unroll") for (int i = 0; i < NQ; ++i) { const int p = tid + 512 * i, row = p / (DK / 8), c8 = p % (DK / 8); const unsigned o_ = (unsigned)(rb_ + row) * QGLD + h * DK + c8 * 8; qreg[i] = *(const u32x4*)(QG + o_); kreg[i] = *(const u32x4*)(KG + o_); }     \
        _Pragma("unroll") for (int i = 0; i < NVP; ++i) { const int p = tid + 512 * i, row = p / (VS / 8), c8 = p % (VS / 8); vreg[i] = *(const u32x4*)(P + ((unsigned)(rb_ + row) * PLD + VOFF + h * DV + vsl * VS + c8 * 8)); } } while (0)
        SCAN_LOAD(0);
        float cv[32]; unsigned char* cdst = nullptr; bool cact = false;
#define SCAN_CONV_ISSUE(cn_) do { const int hh = (cn_) * (4 * 256) + (int)blockIdx.x * 4 + (w - NVW), rq_ = cvt_first + (hh >> 1); \
                cact = GLA && (cn_) < 36 && rq_ < cvt_end; const int r = cact ? rq_ : 16 * 52 + 16 * 16;     \
                {   const int r2 = r - (16 * 52 + 16 * 16), e = r2 / 1792, r3 = r2 % 1792, kt = r3 / 112, n0 = (r3 % 112) * 64, pn = n0 >> 8, p = n0 & 255, bj = p >> 7, rr = p & 127, k0 = kt * 64 + (hh & 1) * 32; \
                    const float* base = bj ? F.ap->in[I_MWU] : F.ap->in[I_MWG]; \
                    const float* csrc = base + (size_t)(j2 * 8 + e) * 1024 * DFFE + 128 * pn + rr + (size_t)k0 * DFFE + lane; \
                    cdst = F.ws + WS_WGLA + WG_GU + ((size_t)e * 7168 + n0) * 1024 + k0; \
                    _Pragma("unroll") for (int i = 0; i < 32; ++i) cv[i] = __builtin_nontemporal_load(csrc + (size_t)i * DFFE); } } while (0)
        if (GLA && w >= NVW) SCAN_CONV_ISSUE(0);
        auto chunk_loop = [&](auto conv_tag) __attribute__((always_inline)) { constexpr bool CONV = decltype(conv_tag)::value;
        for (int ci = 0; ci < 36; ++ci) {
            const int rowbase = scan_rowbase(ci, dir, b);
            SCAN_BAR();
            f32x4 ebreg[GLA ? NDT : 1];
            if (CONV) {
            {
#pragma unroll
                for (int i = 0; i < NQ; ++i) { const int p = tid + 512 * i, row = p / (DK / 8), c8 = p % (DK / 8);
                    *(LAS u32x4*)(L + QS_OFF + (row * QLD + c8 * 8) * 2) = qreg[i]; *(LAS u32x4*)(L + KS_OFF + SCAN_KROW(row) + c8 * 16) = kreg[i];
                    { const int q4 = c8 & 3, pp = 32 * (c8 >> 2) + 16 * (q4 & 1) + 4 * (q4 >> 1); LAS unsigned char* qd2 = L + QP_OFF + (row * QLD + pp) * 2;
                      u32x2 lo2; lo2.x = qreg[i][0]; lo2.y = qreg[i][1]; u32x2 hi2; hi2.x = qreg[i][2]; hi2.y = qreg[i][3]; *(LAS u32x2*)qd2 = lo2; *(LAS u32x2*)(qd2 + 16) = hi2; } }
#pragma unroll
                for (int i = 0; i < NVP; ++i) { const int p = tid + 512 * i, row = p / (VS / 8), c8 = p % (VS / 8); u32x4 vo = vreg[i];
                    if (!GLA) {
#pragma unroll
                        for (int q = 0; q < 4; ++q) vo[q] = pkc(bf_lo(vreg[i][q]) * vsc[i], bf_hi(vreg[i][q]) * vsc[i]); }
                    *(LAS u32x4*)(L + VS_OFF + (row * VLD + c8 * 8) * 2) = vo; }
            }
                if (ci + 1 < 36) SCAN_LOAD(ci + 1);
            } else {
            {
#pragma unroll
                for (int i = 0; i < NQ; ++i) { const int p = tid + 512 * i, row = p / (DK / 8), c8 = p % (DK / 8);
                    *(LAS u32x4*)(L + QS_OFF + (row * QLD + c8 * 8) * 2) = qreg[i]; *(LAS u32x4*)(L + KS_OFF + SCAN_KROW(row) + c8 * 16) = kreg[i];
                    { const int q4 = c8 & 3, pp = 32 * (c8 >> 2) + 16 * (q4 & 1) + 4 * (q4 >> 1); LAS unsigned char* qd2 = L + QP_OFF + (row * QLD + pp) * 2;
                      u32x2 lo2; lo2.x = qreg[i][0]; lo2.y = qreg[i][1]; u32x2 hi2; hi2.x = qreg[i][2]; hi2.y = qreg[i][3]; *(LAS u32x2*)qd2 = lo2; *(LAS u32x2*)(qd2 + 16) = hi2; } }
#pragma unroll
                for (int i = 0; i < NVP; ++i) { const int p = tid + 512 * i, row = p / (VS / 8), c8 = p % (VS / 8); u32x4 vo = vreg[i];
                    if (!GLA) {
#pragma unroll
                        for (int q = 0; q < 4; ++q) vo[q] = pkc(bf_lo(vreg[i][q]) * vsc[i], bf_hi(vreg[i][q]) * vsc[i]); }
                    *(LAS u32x4*)(L + VS_OFF + (row * VLD + c8 * 8) * 2) = vo; }
            }
                if (ci + 1 < 36) SCAN_LOAD(ci + 1);
                if (GLA) { const float* eb = EBG + ((unsigned)((rowbase >> 6) * 2 + dir) * 512 + h * 128 + 4 * g);
#pragma unroll
                    for (int dkt = 0; dkt < NDT; ++dkt) ebreg[dkt] = *(const f32x4*)(eb + 16 * dkt); }
            }
            SCAN_BAR();
            {   const int ib = w >> 1; constexpr int NG = NS / 2;
                s16x8 fa[2][2], fb[2][2]; f32x4 acc2[2];
                acc2[0] = (f32x4){0.f, 0.f, 0.f, 0.f}; acc2[1] = (f32x4){0.f, 0.f, 0.f, 0.f};
#define SCAN_LDB(buf, u) do { const int jb_ = 2 * (w & 1) + (u) / NG; _Pragma("unroll") for (int k = 0; k < 2; ++k) { const int s_ = 2 * ((u) % NG) + k; \
                    fa[buf][k] = *(const LAS s16x8*)(L + KS_OFF + SCAN_KROW(16 * jb_ + l15) + (32 * s_ + 8 * g) * 2); fb[buf][k] = *(const LAS s16x8*)(L + QS_OFF + ((16 * ib + l15) * QLD + 32 * s_ + 8 * g) * 2); } } while (0)
                SCAN_LDB(0, 0);
#pragma unroll
                for (int u = 0; u < 2 * NG; ++u) {
                    if (u + 1 < 2 * NG) SCAN_LDB((u + 1) & 1, u + 1);
                    __builtin_amdgcn_sched_barrier(0);
#pragma unroll
                    for (int k = 0; k < 2; ++k) acc2[u / NG] = MFMA16(fa[u & 1][k], fb[u & 1][k], acc2[u / NG]);
                    __builtin_amdgcn_sched_barrier(0);
                }
#undef SCAN_LDB
                const int i = 16 * ib + l15;
#pragma unroll
                for (int tl = 0; tl < 2; ++tl) { const int jb = 2 * (w & 1) + tl; f32x4 acc = acc2[tl];
#pragma unroll
                    for (int r = 0; r < 4; ++r) { const int j = 16 * jb + 4 * g + r; const bool keep = dir ? (j >= i) : (j <= i); acc[r] = keep ? acc[r] : 0.f; }
                    u32x2 o; o.x = pkc(acc[0], acc[1]); o.y = pkc(acc[2], acc[3]);
                    *(LAS u32x2*)(L + PM_OFF + (i * PLDS + 16 * jb + 4 * g) * 2) = o; }
            }
            SCAN_BAR();
            if (!CONV && (NVW == NWAVES || w < NVW)) {   constexpr int NQG = NS, NKG = NDT / 2;
                s16x8 vf[2], fr[2][4];
#pragma unroll
                for (int ks = 0; ks < 2; ++ks) { LAS unsigned char* vp = L + VS_OFF + ((32 * ks + 8 * g + tq) * VLD + 16 * w + 4 * tp) * 2; vf[ks] = cat8(tr_rd(vp), tr_rd(vp + 4 * VLD * 2)); }
#define SCAN_LDP(buf, ks) do { _Pragma("unroll") for (int nb = 0; nb < 4; ++nb) fr[buf][nb] = *(const LAS s16x8*)(L + PM_OFF + ((16 * nb + l15) * PLDS + 32 * (ks) + 8 * g) * 2); } while (0)
                SCAN_LDP(0, 0);
#define SCAN_LDQ(buf, gq) do { _Pragma("unroll") for (int nb = 0; nb < 4; ++nb) fr[buf][nb] = *(const LAS s16x8*)(L + QP_OFF + ((16 * nb + l15) * QLD + 32 * (gq) + 8 * g) * 2); } while (0)
#define SCAN_LDK(buf, gk) do { _Pragma("unroll") for (int dd = 0; dd < 2; ++dd) _Pragma("unroll") for (int ks = 0; ks < 2; ++ks) { LAS unsigned char* kp = L + KS_OFF + SCAN_KROW(32 * ks + 8 * g + tq) + (16 * (2 * (gk) + dd) + 4 * tp) * 2; \
                    fr[buf][dd * 2 + ks] = cat8(tr_rd(kp), tr_rd(kp + 4 * KLD * 2)); } } while (0)
                f32x4 T[4];
#pragma unroll
                for (int nb = 0; nb < 4; ++nb) T[nb] = (f32x4){0.f, 0.f, 0.f, 0.f};
                SCAN_LDP(1, 1);
                __builtin_amdgcn_sched_barrier(0);
#pragma unroll
                for (int nb = 0; nb < 4; ++nb) T[nb] = MFMA16(vf[0], fr[0][nb], T[nb]);
                __builtin_amdgcn_sched_barrier(0);
                SCAN_LDQ(0, 0);
                __builtin_amdgcn_sched_barrier(0);
#pragma unroll
                for (int nb = 0; nb < 4; ++nb) T[nb] = MFMA16(vf[1], fr[1][nb], T[nb]);
                __builtin_amdgcn_sched_barrier(0);
#undef SCAN_LDP
#pragma unroll
                for (int gq = 0; gq < NQG; ++gq) {
                    if (gq + 1 < NQG) SCAN_LDQ((gq + 1) & 1, gq + 1); else SCAN_LDK((gq + 1) & 1, 0);
                    __builtin_amdgcn_sched_barrier(0);
                    {   const int s = gq;
                        u32x4 sp; sp.x = pkc(S[2 * s][0], S[2 * s][1]); sp.y = pkc(S[2 * s][2], S[2 * s][3]); sp.z = pkc(S[2 * s + 1][0], S[2 * s + 1][1]); sp.w = pkc(S[2 * s + 1][2], S[2 * s + 1][3]);
                        const s16x8 sf = __builtin_bit_cast(s16x8, sp);
#pragma unroll
                        for (int nb = 0; nb < 4; ++nb) T[nb] = MFMA16(sf, fr[gq & 1][nb], T[nb]); }
                    __builtin_amdgcn_sched_barrier(0);
                }
#pragma unroll
                for (int nb = 0; nb < 4; ++nb) { const f32x4 tv = T[nb] * qd[nb]; u32x2 o; o.x = pkc(tv[0], tv[1]); o.y = pkc(tv[2], tv[3]);
                    *(u32x2*)(O + ((unsigned)(rowbase + 16 * nb + l15) * OLD + h * DV + vsl * VS + 16 * w + 4 * g)) = o; }
#pragma unroll
                for (int gk = 0; gk < NKG; ++gk) {
                    if (gk + 1 < NKG) SCAN_LDK((NQG + gk + 1) & 1, gk + 1);
                    __builtin_amdgcn_sched_barrier(0);
#pragma unroll
                    for (int ks = 0; ks < 2; ++ks)
#pragma unroll
                        for (int dd = 0; dd < 2; ++dd) S[2 * gk + dd] = MFMA16(fr[(NQG + gk) & 1][dd * 2 + ks], vf[ks], S[2 * gk + dd]);
                    __builtin_amdgcn_sched_barrier(0);
                }
#undef SCAN_LDQ
#undef SCAN_LDK
                if (GLA) {
#pragma unroll
                    for (int dkt = 0; dkt < NDT; ++dkt) S[dkt] = S[dkt] * ebreg[dkt];
                } else {
#pragma unroll
                    for (int dkt = 0; dkt < NDT; ++dkt) S[dkt] = S[dkt] * gC;
                }
            } else if (CONV) { if (cact) {
                LAS unsigned* scr = (LAS unsigned*)(L + 90112 + (w - NVW) * 4096);
#pragma unroll
                for (int i = 0; i < 8; ++i) scr[lane * 9 + i] = pg8::pack4_fp8(cv[4 * i] * MOE_WGU_SCALE, cv[4 * i + 1] * MOE_WGU_SCALE, cv[4 * i + 2] * MOE_WGU_SCALE, cv[4 * i + 3] * MOE_WGU_SCALE);
                asm volatile("s_waitcnt lgkmcnt(0)" ::: "memory");
#pragma unroll
                for (int jj = 0; jj < 2; ++jj) { const int n = (lane >> 1) + 32 * jj, c = lane & 1; const LAS unsigned* q = scr + n * 9 + 4 * c;
                    u32x4 o; o.x = q[0]; o.y = q[1]; o.z = q[2]; o.w = q[3];
                    __builtin_nontemporal_store(o, (u32x4*)(cdst + (size_t)n * 1024 + 16 * c)); }
                asm volatile("s_waitcnt lgkmcnt(0)" ::: "memory"); }
                SCAN_CONV_ISSUE(ci + 1);
            }
        }
        };
        if (GLA && w >= NVW) chunk_loop(ScanTagT{}); else chunk_loop(ScanTagF{});
#undef SCAN_CONV_ISSUE
#undef SCAN_LOAD
#undef SCAN_KROW
        __syncthreads();
    }
}

DI void ph_gate_prep(Frame& F, int j2) {
    const int lane = F.lane;
    LAS float* as = (LAS float*)(F.lds + F.wave * 4096);
    const bf16* P = (const bf16*)(F.ws + WS_P); const float* AF = (const float*)(F.ws + WS_AF);
    bf16* QT = (bf16*)(F.ws + WS_QT); float* EBG = (float*)(F.ws + WS_EB);
    constexpr int NIT = (NTOK / 64) * 8;
    for (int k = 0; ; ++k) {
        const int it = k == 0 ? F.gw : F.NGW + (int)blockIdx.x + F.G * (F.wave + NWAVES * (k - 1));
        if (it >= NIT) break;
        const int h = it & 3, dir = (it >> 2) & 1, c = it >> 3, rowbase = c * 64, col = h * 128 + 2 * lane;
        LDS_WAIT();
        float at[16];
#pragma unroll
        for (int i = 0; i < 16; ++i) { const int idx = lane + 64 * i; at[i] = AF[(size_t)(rowbase + (idx >> 4)) * 32 + dir * 16 + (idx & 15)]; }
#pragma unroll
        for (int i = 0; i < 16; ++i) as[lane + 64 * i] = at[i];
        float w0[16], w1[16];
        const float* wp = F.ap->in[I_GWUP] + (size_t)((j2 * 2 + dir) * 16) * 512 + col;
#pragma unroll
        for (int r = 0; r < 16; ++r) { const f32x2 wv = *(const f32x2*)(wp + (size_t)r * 512); w0[r] = wv[0]; w1[r] = wv[1]; }
        const f32x2 bgv = *(const f32x2*)(F.ap->in[I_GBG] + (j2 * 2 + dir) * 512 + col);
        bf16* qo = QT + (size_t)dir * NTOK * 512; bf16* ko = QT + (size_t)(2 + dir) * NTOK * 512;
        LDS_WAIT();
        float b0 = 0.f, b1 = 0.f;
        for (int p8 = 0; p8 < 8; ++p8) {
            unsigned qv[8], kv[8];
#pragma unroll
            for (int u = 0; u < 8; ++u) { const int pi = 8 * p8 + u, tok = dir ? 63 - pi : pi; const bf16* rp = P + (size_t)(rowbase + tok) * GLA_INP + col; qv[u] = *(const unsigned*)rp; kv[u] = *(const unsigned*)(rp + 1536); }
#pragma unroll
            for (int u = 0; u < 8; ++u) { const int pi = 8 * p8 + u, tok = dir ? 63 - pi : pi;
                float z0 = bgv[0], z1 = bgv[1];
#pragma unroll
                for (int r4 = 0; r4 < 4; ++r4) { const f32x4 av = *(const LAS f32x4*)(as + tok * 16 + 4 * r4);
#pragma unroll
                    for (int q = 0; q < 4; ++q) { z0 += av[q] * w0[4 * r4 + q]; z1 += av[q] * w1[4 * r4 + q]; } }
                b0 += (fminf(z0, 0.f) - __logf(1.0f + __expf(-fabsf(z0)))) * (1.0f / 16.0f);
                b1 += (fminf(z1, 0.f) - __logf(1.0f + __expf(-fabsf(z1)))) * (1.0f / 16.0f);
                const float e0 = __expf(b0), e1 = __expf(b1), i0 = __builtin_amdgcn_rcpf(e0), i1 = __builtin_amdgcn_rcpf(e1);
                const size_t o = (size_t)(rowbase + tok) * 512 + col;
                *(unsigned*)(qo + o) = pkc(bf_lo(qv[u]) * e0, bf_hi(qv[u]) * e1);
                *(unsigned*)(ko + o) = pkc(bf_lo(kv[u]) * i0, bf_hi(kv[u]) * i1);
            }
        }
        f32x2 ev; ev[0] = __expf(b0); ev[1] = __expf(b1);
        *(f32x2*)(EBG + (size_t)(c * 2 + dir) * 512 + col) = ev;
    }
}

#ifndef SCAN_RET_MFMA
#define SCAN_RET_MFMA 1
#endif
#ifndef SCAN_GLA_MFMA
#define SCAN_GLA_MFMA 1
#endif
#ifndef PROBE_MASK
#define PROBE_MASK 0
#endif
constexpr int NPHASES = 1 + 8 + 9 + 8 + 9 + 1 + ((PROBE_MASK & 128) ? 2 : 0) + ((PROBE_MASK & 256) ? 2 : 0);
#define REP(bit) for (int rep_ = 0; rep_ < ((PROBE_MASK & (bit)) ? 2 : 1); ++rep_)
#ifndef CVT_BUDGET_K1024
#define CVT_BUDGET_K1024 4
#define CVT_BUDGET_K2048 8
#define CVT_BUDGET_K2816 12
#define CVT_BUDGET_K3584 16
#define CVT_BUDGET_GLASCAN 8
#endif
#ifndef GU_TAIL
#define GU_TAIL 4
#define IN_TAIL 2
#define DN_TAIL 4
#endif
constexpr int TAIL_GU = 208 * NWAVES * GU_TAIL, TAIL_IN = 64 * NWAVES * IN_TAIL;
constexpr int SCAN_CVT_FIRST = 16 * 52 + 16 * 16;
static_assert(CVT_GLA_ITEMS - TAIL_GU - TAIL_IN - SCAN_CVT_FIRST <= 36 * 1024 / 2 && CVT_GLA_ITEMS - TAIL_GU - TAIL_IN <= 16 * 52 + 16 * 16 + 8 * 16 * 112, "in-scan conversion: capacity, and gate/up tiles only");
#ifndef CTX_SPLIT
#define CTX_SPLIT 1
#endif
#ifndef N_LAUNCH_MODE
#define N_LAUNCH_MODE 1
#endif

__global__ void __launch_bounds__(NWAVES * 64, 2) fwd(Args args) {
    extern __shared__ __attribute__((aligned(16))) unsigned char lds_raw[];
    Frame F;
    F.lds = (LAS unsigned char*)lds_raw;
    F.tid = threadIdx.x; F.lane = F.tid & 63; F.wave = __builtin_amdgcn_readfirstlane(F.tid >> 6);
    F.G = gridDim.x; F.gw = blockIdx.x * NWAVES + F.wave; F.NGW = F.G * NWAVES;
    F.ws = args.ws; F.out = args.out;
    F.ap = (const __attribute__((address_space(4))) Args*)__builtin_amdgcn_kernarg_segment_ptr();
    volatile LAS unsigned* MISC = (volatile LAS unsigned*)(F.lds + MISC_OFF);
    if (F.tid < 32) MISC[F.tid] = 0u;
    __syncthreads();
    const int lo = args.lo, hi = args.hi;
    unsigned* barw = (unsigned*)(F.ws + WS_CTL) + CW_BAR;
    XcdBarrier bar; bar.bar = barw; bar.x = 0; bar.st = MISC + 8;
    if (hi - lo > 1) bar = xcd_barrier_post(barw, MISC + 8);
    int ph = 0;
#define PHASE_BEGIN if (ph >= lo && ph < hi) { { int ln_; asm volatile("v_mbcnt_lo_u32_b32 %0, -1, 0\n\tv_mbcnt_hi_u32_b32 %0, -1, %0" : "=v"(ln_)); F.lane = ln_; F.tid = F.wave * 64 + ln_; } asm volatile("" : "+s"(F.ap)); asm volatile("" : "+s"(F.gw));
#ifndef SITE_MASK
#define SITE_MASK 0xFFFFFFFFu
#endif
#define SITE(k) if (SITE_MASK & (1u << (k)))
#define PHASE_END   if (ph + 1 < hi) { xcd_barrier(bar); if (PROBE_MASK & 64) xcd_barrier(bar); } } ++ph;
    const float* mods = (const float*)(F.ws + WS_MODS);
    bf16* HA = (bf16*)(F.ws + WS_HA); bf16* TOK = (bf16*)(F.ws + WS_TOK); const float* const NOF32 = nullptr;

    PHASE_BEGIN SITE(0) { REP(4) { __syncthreads(); ph_prologue(F); } REP(2) cvt_layer_static(F, 0); } PHASE_END

    for (int layer = 0; layer < DEPTH; ++layer) {
        const int j2 = layer >> 1; const int rlo = (layer == DEPTH - 1) ? NCTX : 0;
        if ((layer & 1) == 0) {
            const bf16* W = (const bf16*)(F.ws + WS_WRET);
            PHASE_BEGIN SITE(1) { const int lpos = __builtin_amdgcn_readfirstlane(layer > 0 ? 1 : 0);
                                  int cvt_done = 0;
                                  if (lpos != 0 && F.G == 256) { int cnt_[8]; moe_counts(F, (layer - 1) >> 1, cnt_); int nm_ = 0;
#pragma unroll
                                      for (int e = 0; e < 8; ++e) nm_ += (cnt_[e] + 255) >> 8;
                                      const int busy_ = nm_ * 4 * MOE_KSPLIT - 2 * 256; if (busy_ >= 0 && busy_ <= 96) cvt_done = CVT_RET_ITEMS; }
                                  REP(4) ph_norm<0>(F, layer, 0, lpos != 0 && rep_ == 0, 0, layer == 0 ? F.ap->in[I_CTX] : NOF32, layer == 0 ? F.ap->in[I_X] - (size_t)NCTX * D : NOF32, 0, mods, (lpos != 0 && rep_ == 0) ? layer : -1, 1, 1 << 30, cvt_done); } PHASE_END
            PHASE_BEGIN SITE(2) { REP(8) { pg8::Gemm g{HA, W + WR_IN / 2, NTOK, RET_IN, D}; pg8::StaticOrder S; S.init(NTOK, RET_IN, F.G, (int)blockIdx.x, D);
                          pg8::EpiRetIn E{(bf16*)(F.ws + WS_P), (const float*)(F.ws + WS_ROPE), (const float*)(F.ws + WS_ROPE) + 4096};
                          pg8::gemm_phase<pg8::EpiRetIn, pg8::StaticOrder, true, true>(F.lds, g, S, E, F.tid);
                          if (F.G == 256 && rep_ == 0 && (int)blockIdx.x >= 192) cvt_part(F, layer + 1, CVT_GLA_ITEMS - TAIL_GU - TAIL_IN, CVT_GLA_ITEMS - TAIL_GU, ((int)blockIdx.x - 192) * NWAVES + F.wave, IN_TAIL); } } PHASE_END
            PHASE_BEGIN SITE(3) { REP(1 | 16) if (SCAN_RET_MFMA) ph_scan_mfma<false>(F, j2); else ph_scan_naive<false>(F, j2); } PHASE_END
            PHASE_BEGIN SITE(4) { REP(4) ph_finish<false>(F, j2, 0); } PHASE_END
            PHASE_BEGIN SITE(5) { { pg8::Gemm g{(const bf16*)(F.ws + WS_A2), W + WR_OUT / 2, NTOK, D, 2048}; pg8::ResidOrder S; S.init(NTOK, D, F.G, (int)blockIdx.x, 2048, CTX_SPLIT ? NCTX / 256 : 0, 8);
                          pg8::EpiResid E{TOK, layer == 0 ? F.ap->in[I_X] - (size_t)NCTX * D : NOF32, layer == 0 ? F.ap->in[I_CTX] : NOF32, mods + (size_t)layer * 9 * 6144 + 2048, 0, (bf16*)(F.ws + WS_PS), CTX_SPLIT ? NCTX / 256 : 0};
                          pg8::gemm_phase<pg8::EpiResid, pg8::ResidOrder, true, true>(F.lds, g, S, E, F.tid); } } PHASE_END
            PHASE_BEGIN SITE(6) { REP(4) ph_norm<0, true>(F, layer, 1, false, 0, (CTX_SPLIT && layer == 0) ? F.ap->in[I_CTX] : NOF32, NOF32, (CTX_SPLIT && rep_ == 0) ? 8 : 0, mods + (size_t)(layer * 9 + 8) * 6144 + 2048); } PHASE_END
            PHASE_BEGIN SITE(7) { REP(8) { pg8::Gemm g{HA, W + WR_GU / 2, NTOK, 2 * DFF, D}; pg8::StaticOrder S; S.init(NTOK, 2 * DFF, F.G, (int)blockIdx.x, D);
                          pg8::EpiSwigluF8 E{(unsigned char*)(F.ws + WS_HID), DFF};
                          pg8::gemm_phase<pg8::EpiSwigluF8, pg8::StaticOrder, true, true>(F.lds, g, S, E, F.tid);
                          if (F.G == 256 && rep_ == 0 && (int)blockIdx.x >= 48) cvt_part(F, layer + 1, CVT_GLA_ITEMS - TAIL_GU, CVT_GLA_ITEMS, ((int)blockIdx.x - 48) * NWAVES + F.wave, GU_TAIL); } } PHASE_END
            if (PROBE_MASK & 128) { PHASE_BEGIN SITE(20) { pg8::Gemm g{HA, W + WR_GU / 2, NTOK, 2 * DFF, D}; pg8::StaticOrder S; S.init(NTOK, 2 * DFF, F.G, (int)blockIdx.x, D);
                          pg8::EpiNull E{}; pg8::gemm_phase<pg8::EpiNull, pg8::StaticOrder, true, true>(F.lds, g, S, E, F.tid); } PHASE_END }
            if (PROBE_MASK & 256) { PHASE_BEGIN SITE(21) { pg8::Gemm g{HA, W + WR_GU / 2, NTOK, 2 * DFF, D}; pg8::StaticOrder S; S.init(NTOK, 2 * DFF, F.G, (int)blockIdx.x, D);
                          pg8::EpiSwiglu E{(bf16*)(F.ws + WS_OF), DFF}; pg8::gemm_phase<pg8::EpiSwiglu, pg8::StaticOrder, true, true>(F.lds, g, S, E, F.tid); } PHASE_END }
            PHASE_BEGIN SITE(8) { { pg8::Gemm g{(const bf16*)(F.ws + WS_HID), (const bf16*)(F.ws + WS_WRET + WR_DN), NTOK, D, DFF / 2, E8M0_2M7, E8M0_2M1}; pg8::ResidOrder S; S.init(NTOK, D, F.G, (int)blockIdx.x, DFF / 2, CTX_SPLIT ? NCTX / 256 : 0, 4);
                          pg8::EpiResid E{TOK, NOF32, NOF32, mods + (size_t)layer * 9 * 6144 + 5120, 0, (bf16*)(F.ws + WS_PS), CTX_SPLIT ? NCTX / 256 : 0};
                          pg8::gemm_phase<pg8::EpiResid, pg8::ResidOrder, true, true, true>(F.lds, g, S, E, F.tid); } } PHASE_END
        } else {
            const bf16* W = (const bf16*)(F.ws + WS_WGLA);
            PHASE_BEGIN SITE(9) { REP(4) ph_norm<0>(F, layer, 0, false, 0, NOF32, NOF32, (CTX_SPLIT && rep_ == 0) ? 4 : 0, mods + (size_t)((layer - 1) * 9 + 8) * 6144 + 5120, rep_ == 0 ? layer : -1, 2, F.G == 256 ? SCAN_CVT_FIRST : (1 << 30)); } PHASE_END
            PHASE_BEGIN SITE(10) { REP(8) { pg8::Gemm g{HA, W + WG_IN / 2, NTOK, GLA_INP, D}; pg8::StaticOrder S; S.init(NTOK, GLA_INP, F.G, (int)blockIdx.x, D);
                          pg8::EpiGlaIn E{(bf16*)(F.ws + WS_P), (float*)(F.ws + WS_AF)};
                          pg8::gemm_phase<pg8::EpiGlaIn, pg8::StaticOrder, true, true>(F.lds, g, S, E, F.tid); } } PHASE_END
            PHASE_BEGIN SITE(19) { REP(32) ph_gate_prep(F, j2); } PHASE_END
            PHASE_BEGIN SITE(11) { REP(1 | 32) if (SCAN_GLA_MFMA) ph_scan_mfma<true>(F, j2, (F.G == 256 && rep_ == 0) ? SCAN_CVT_FIRST : 0, (F.G == 256 && rep_ == 0) ? CVT_GLA_ITEMS - TAIL_GU - TAIL_IN : 0); else ph_scan_naive<true>(F, j2); } PHASE_END
            PHASE_BEGIN SITE(12) { REP(4) ph_finish<true>(F, j2, rlo); } PHASE_END
            PHASE_BEGIN SITE(13) { { pg8::Gemm g{(const bf16*)(F.ws + WS_A2) + (size_t)rlo * 1024, W + WG_OUT / 2, NTOK - rlo, D, D}; pg8::ResidOrder S; S.init(NTOK - rlo, D, F.G, (int)blockIdx.x, D, CTX_SPLIT ? (NCTX - rlo) / 256 : 0, 4);
                          pg8::EpiResid E{TOK, NOF32, NOF32, mods + (size_t)layer * 9 * 6144 + 2048, rlo, (bf16*)(F.ws + WS_PS), CTX_SPLIT ? (NCTX - rlo) / 256 : 0};
                          pg8::gemm_phase<pg8::EpiResid, pg8::ResidOrder, true, true>(F.lds, g, S, E, F.tid); } } PHASE_END
            PHASE_BEGIN SITE(14) { ph_norm<1, true>(F, layer, 1, false, rlo, NOF32, NOF32, (CTX_SPLIT && rlo == 0) ? 4 : 0, mods + (size_t)(layer * 9 + 8) * 6144 + 2048); if (PROBE_MASK & 4) ph_norm<0>(F, layer, 1, false, rlo, NOF32, NOF32, 0, mods); } PHASE_END
            PHASE_BEGIN SITE(16) { REP(8) { pg8::MoeOrder S; moe_order(F, j2, 28, 1, D / 128, S); pg8::Gemm g{(const bf16*)(F.ws + WS_HA), (const bf16*)(F.ws + WS_WGLA + WG_GU), S.nM * 256, 7168, D / 2, E8M0_2M6, E8M0_1, (const int*)(F.ws + WS_RINFO)};
                          pg8::EpiSwigluF8 E{(unsigned char*)(F.ws + WS_HIDG), DFFE};
                          pg8::gemm_phase<pg8::EpiSwigluF8, pg8::MoeOrder, true, true, true, true>(F.lds, g, S, E, F.tid); } } PHASE_END
            PHASE_BEGIN SITE(17) { REP(8) { pg8::MoeOrder S; moe_order(F, j2, 4, MOE_KSPLIT, DFFE / 128, S); pg8::Gemm g{(const bf16*)(F.ws + WS_HIDG), (const bf16*)(F.ws + WS_WGLA + WG_DN), S.nM * 256, D, DFFE / 2, E8M0_2M7, E8M0_2M1};
                          pg8::EpiMoeDown E{(bf16*)(F.ws + WS_YB), (const int*)(F.ws + WS_RINFO), (const float*)(F.ws + WS_RW)};
                          pg8::gemm_phase<pg8::EpiMoeDown, pg8::MoeOrder, true, true, true>(F.lds, g, S, E, F.tid);
                          { const int busy = S.nwg - 2 * 256; if (F.G == 256 && rep_ == 0 && busy >= 0 && busy <= 96 && (int)blockIdx.x >= busy) cvt_part(F, layer + 1, 0, CVT_RET_ITEMS, ((int)blockIdx.x - busy) * NWAVES + F.wave, DN_TAIL); } } } PHASE_END
        }
    }
    PHASE_BEGIN SITE(18) { REP(4) ph_norm<2>(F, DEPTH, 0, true, NCTX, NOF32, NOF32, 0, mods); } PHASE_END
#undef PHASE_BEGIN
#undef PHASE_END
}

extern "C" void kernel_launch(void* const* d_in, const int* in_sizes, int n_in, void* d_out, int out_size, void* d_ws, size_t ws_size, hipStream_t stream) {
    static int grid = 0;
    if (grid == 0) {
        if (n_in != 26 || in_sizes[0] != NLAT * D || out_size != NLAT * D || ws_size < WS_END) {
            fprintf(stderr, "kernel_launch: unexpected shapes: n_in %d in0 %d out %d ws %zu (need %zu)\n", n_in, n_in > 0 ? in_sizes[0] : -1, out_size, ws_size, (size_t)WS_END); grid = -1; return; }
        int dev = 0, cus = 0, per_cu = 0;
        if (hipGetDevice(&dev) != hipSuccess || hipDeviceGetAttribute(&cus, hipDeviceAttributeMultiprocessorCount, dev) != hipSuccess) { grid = -1; return; }
        if (hipFuncSetAttribute((const void*)fwd, hipFuncAttributeMaxDynamicSharedMemorySize, LDS_BYTES) != hipSuccess) { fprintf(stderr, "kernel_launch: hipFuncSetAttribute failed\n"); grid = -1; return; }
        if (hipOccupancyMaxActiveBlocksPerMultiprocessor(&per_cu, (const void*)fwd, NWAVES * 64, LDS_BYTES) != hipSuccess || per_cu < 1)
            fprintf(stderr, "kernel_launch: note: occupancy query reports %d workgroups per CU\n", per_cu);
        (void)hipGetLastError();
        grid = cus;
    }
    if (grid < 0) return;
    if (hipMemsetAsync((char*)d_ws + WS_CTL, 0, CTL_ZERO_BYTES, stream) != hipSuccess) { fprintf(stderr, "kernel_launch: memset failed\n"); return; }
    Args a{};
    for (int i = 0; i < 26; ++i) a.in[i] = (const float*)d_in[i];
    a.out = (float*)d_out; a.ws = (unsigned char*)d_ws;
#if N_LAUNCH_MODE == 1
    a.lo = 0; a.hi = NPHASES;
    hipLaunchKernelGGL(fwd, dim3(grid), dim3(NWAVES * 64), LDS_BYTES, stream, a);
#else
    for (int p = 0; p < NPHASES; ++p) { a.lo = p; a.hi = p + 1; hipLaunchKernelGGL(fwd, dim3(grid), dim3(NWAVES * 64), LDS_BYTES, stream, a); }
#endif
}
```
